# Optimizing an MI355X kernel written in HIP

```python
import math
import jax, jax.numpy as jnp
from jax import lax
import numpy as np

D_MODEL = 1024
BATCH = 16
SEQ = 4096
DEPTH = 2

CONV_WIDTH = D_MODEL // 2
CONV_KERNEL = 31
N_HEADS = 8
HEAD_DIM = 64
ATT_WIDTH = N_HEADS * HEAD_DIM
N_BRANCH = 2
D_FF = -(-8 * D_MODEL // (3 * 256)) * 256
IN_COLS = 2 * CONV_WIDTH + 3 * ATT_WIDTH + N_BRANCH * D_MODEL
Q_BLOCK = 128
EPS = 1e-6

kernel_name = "hybrid_conformer_stickbreaking_block"


def rmsnorm(x, g):
    xf = x.astype(jnp.float32)
    y = xf * lax.rsqrt(jnp.mean(xf * xf, axis=-1, keepdims=True) + EPS)
    return (y * g.astype(jnp.float32)).astype(x.dtype)


def layernorm(x, g, b):
    xf = x.astype(jnp.float32)
    mu = jnp.mean(xf, axis=-1, keepdims=True)
    xc = xf - mu
    y = xc * lax.rsqrt(jnp.mean(xc * xc, axis=-1, keepdims=True) + EPS)
    return (y * g.astype(jnp.float32) + b.astype(jnp.float32)).astype(x.dtype)


def causal_depthwise_conv(u, w, b):
    ch = u.shape[-1]
    y = lax.conv_general_dilated(
        u, w[:, None, :].astype(u.dtype), window_strides=(1,), padding=[(CONV_KERNEL - 1, 0)],
        dimension_numbers=("NWC", "WIO", "NWC"), feature_group_count=ch)
    return y + b


def stick_breaking_attention(q, k, v):
    s_len = q.shape[1]
    scale = 1.0 / math.sqrt(q.shape[-1])
    qf = q.astype(jnp.float32) * scale
    kf = k.astype(jnp.float32)
    vf = v.astype(jnp.float32)
    outs = []
    for start in range(0, s_len, Q_BLOCK):
        end = start + Q_BLOCK
        z = jnp.einsum("bqhd,bkhd->bhqk", qf[:, start:end], kf[:, :end])
        t_idx = start + jnp.arange(Q_BLOCK)[:, None]
        s_idx = jnp.arange(end)[None, :]
        causal = s_idx < t_idx
        log_keep = jnp.where(causal, jax.nn.log_sigmoid(-z), 0.0)
        log_after = lax.cumsum(log_keep, axis=3, reverse=True) - log_keep
        a = jnp.where(causal, jnp.exp(jax.nn.log_sigmoid(z) + log_after), 0.0)
        outs.append(jnp.einsum("bhqk,bkhd->bqhd", a, vf[:, :end]))
    return jnp.concatenate(outs, axis=1).astype(q.dtype)


def hybrid_mixer(h, w_in, conv_w, conv_b, conv_ln_g, conv_ln_b, w_conv_out, w_att_out, w_o):
    b, s, _ = h.shape
    proj = h @ w_in
    glu_in, qkv, gates = jnp.split(proj, [2 * CONV_WIDTH, 2 * CONV_WIDTH + 3 * ATT_WIDTH], axis=-1)
    u_val, u_gate = jnp.split(glu_in, 2, axis=-1)
    u = u_val * jax.nn.sigmoid(u_gate)
    u = causal_depthwise_conv(u, conv_w, conv_b)
    u = jax.nn.silu(layernorm(u, conv_ln_g, conv_ln_b))
    y_conv = u @ w_conv_out
    qkv = qkv.reshape(b, s, 3, N_HEADS, HEAD_DIM)
    o = stick_breaking_attention(qkv[:, :, 0], qkv[:, :, 1], qkv[:, :, 2])
    y_att = o.reshape(b, s, ATT_WIDTH) @ w_att_out
    g_conv, g_att = jnp.split(gates, 2, axis=-1)
    merged = jax.nn.sigmoid(g_conv) * y_conv + jax.nn.sigmoid(g_att) * y_att
    return merged @ w_o


def swiglu_ffn(h, w_ffn_in, w_ffn_out):
    gate, up = jnp.split(h @ w_ffn_in, 2, axis=-1)
    return (jax.nn.silu(gate) * up) @ w_ffn_out


def _normal(k, shape, scale):
    return jax.random.normal(k, shape, jnp.float32) * scale


def setup_inputs(seed: int = 0) -> dict:
    key = jax.random.key(seed)
    ks = jax.random.split(key, 20)
    D = D_MODEL
    return {
        "x": _normal(ks[0], (BATCH, SEQ, D), 1.0),
        "c": _normal(ks[1], (BATCH, D), 1.0),
        "ada_w": _normal(ks[2], (DEPTH, D, 6 * D), D ** -0.5),
        "ada_b": _normal(ks[3], (DEPTH, 6 * D), 0.02),
        "pre_mix_g": 1.0 + _normal(ks[4], (DEPTH, D), 0.02),
        "post_mix_g": 1.0 + _normal(ks[5], (DEPTH, D), 0.02),
        "pre_ffn_g": 1.0 + _normal(ks[6], (DEPTH, D), 0.02),
        "post_ffn_g": 1.0 + _normal(ks[7], (DEPTH, D), 0.02),
        "w_in": _normal(ks[8], (DEPTH, D, IN_COLS), D ** -0.5),
        "conv_w": _normal(ks[9], (DEPTH, CONV_KERNEL, CONV_WIDTH), CONV_KERNEL ** -0.5),
        "conv_b": _normal(ks[10], (DEPTH, CONV_WIDTH), 0.02),
        "conv_ln_g": 1.0 + _normal(ks[11], (DEPTH, CONV_WIDTH), 0.02),
        "conv_ln_b": _normal(ks[12], (DEPTH, CONV_WIDTH), 0.02),
        "w_conv_out": _normal(ks[13], (DEPTH, CONV_WIDTH, D), CONV_WIDTH ** -0.5),
        "w_att_out": _normal(ks[14], (DEPTH, ATT_WIDTH, D), ATT_WIDTH ** -0.5),
        "w_o": _normal(ks[15], (DEPTH, D, D), D ** -0.5),
        "w_ffn_in": _normal(ks[16], (DEPTH, D, 2 * D_FF), D ** -0.5),
        "w_ffn_out": _normal(ks[17], (DEPTH, D_FF, D), D_FF ** -0.5),
    }


def reference(x, c, ada_w, ada_b, pre_mix_g, post_mix_g, pre_ffn_g, post_ffn_g, w_in, conv_w, conv_b,
              conv_ln_g, conv_ln_b, w_conv_out, w_att_out, w_o, w_ffn_in, w_ffn_out):
    c_act = jax.nn.silu(c)
    for l in range(DEPTH):
        mod = c_act @ ada_w[l] + ada_b[l]
        sh1, sc1, ga1, sh2, sc2, ga2 = [m[:, None, :] for m in jnp.split(mod, 6, axis=-1)]
        h = rmsnorm(x, pre_mix_g[l]) * (1.0 + sc1) + sh1
        y = hybrid_mixer(h, w_in[l], conv_w[l], conv_b[l], conv_ln_g[l], conv_ln_b[l],
                         w_conv_out[l], w_att_out[l], w_o[l])
        x = x + ga1 * rmsnorm(y, post_mix_g[l])
        h = rmsnorm(x, pre_ffn_g[l]) * (1.0 + sc2) + sh2
        y = swiglu_ffn(h, w_ffn_in[l], w_ffn_out[l])
        x = x + ga2 * rmsnorm(y, post_ffn_g[l])
    return x
```

```cpp
#include <hip/hip_runtime.h>
#include <hip/hip_cooperative_groups.h>
#include <cstdio>
#include <cstdint>
namespace cg = cooperative_groups;

#define DI __device__ __forceinline__
#define LAS __attribute__((address_space(3)))
typedef unsigned short bf16_t;
typedef short bf16x8 __attribute__((ext_vector_type(8)));
typedef short s16x4 __attribute__((ext_vector_type(4)));
typedef float f32x2 __attribute__((ext_vector_type(2)));
typedef float f32x4 __attribute__((ext_vector_type(4)));
typedef float f32x16 __attribute__((ext_vector_type(16)));
typedef unsigned u32x2 __attribute__((ext_vector_type(2)));
typedef unsigned u32x4 __attribute__((ext_vector_type(4)));
typedef __bf16 bf2_t __attribute__((ext_vector_type(2)));

constexpr int D = 1024, NB = 16, SEQ = 4096, M = NB * SEQ, DEPTH = 2;
constexpr int CW = 512, CK = 31, NH = 8, HD = 64, DFF = 2816, INC = 4608;
constexpr float EPS = 1e-6f;
constexpr float LOG2E = 1.4426950408889634f;
constexpr int LDS_BYTES = 135168 + 64;
constexpr int NPHASE = 2 + 8 * DEPTH;

constexpr size_t OFF_MOD = 0;
constexpr size_t OFF_DIAG = 786432;
constexpr size_t OFF_BAR = OFF_DIAG + 256;
constexpr size_t ZERO_BYTES = 256 + 3456 * 4;
constexpr size_t OFF_KN = 802816;
constexpr size_t OFF_WIN = 2097152;
constexpr size_t OFF_WMIX = OFF_WIN + 2ull * INC * D * 2;
constexpr size_t OFF_WO = OFF_WMIX + 2ull * D * D * 2;
constexpr size_t OFF_WF1 = OFF_WO + 2ull * D * D * 2;
constexpr size_t OFF_WF2 = OFF_WF1 + 2ull * 2 * DFF * D * 2;
constexpr size_t OFF_H = 67108864;
constexpr size_t OFF_MIX = OFF_H + (size_t)M * D * 2;
constexpr size_t OFF_R = OFF_MIX + (size_t)M * D * 2;
constexpr size_t OFF_U = OFF_R;
constexpr size_t OFF_QKV = OFF_U + (size_t)M * CW * 2;
constexpr size_t OFF_RATIO = OFF_QKV + (size_t)M * 1536 * 2;
constexpr size_t OFF_SGA = OFF_RATIO + (size_t)M * D * 2;
constexpr size_t OFF_HID = OFF_R;
constexpr size_t WS_END_ACT = OFF_SGA + (size_t)M * D * 2;
constexpr size_t OFF_SS = WS_END_ACT;
constexpr size_t OFF_XB = WS_END_ACT + 4ull * M * 16 * 4;
constexpr size_t WS_END = OFF_XB + (size_t)M * D * 2;
static_assert(OFF_WF2 + 2ull * D * DFF * 2 <= OFF_H, "weights overflow");
static_assert(OFF_HID + (size_t)M * DFF * 2 <= WS_END, "hid overflow");

struct Params {
    const float *x, *c, *ada_w, *ada_b, *pre_mix_g, *post_mix_g, *pre_ffn_g, *post_ffn_g, *w_in, *conv_w, *conv_b, *conv_ln_g, *conv_ln_b,
        *w_conv_out, *w_att_out, *w_o, *w_ffn_in, *w_ffn_out;
    float* out; unsigned char* ws; int ph_lo, ph_hi;
};

DI unsigned pk2(float a, float b) { f32x2 v = {a, b}; bf2_t r = __builtin_convertvector(v, bf2_t); return __builtin_bit_cast(unsigned, r); }
DI float bf_lo(unsigned w) { return __uint_as_float(w << 16); }
DI float bf_hi(unsigned w) { return __uint_as_float(w & 0xffff0000u); }
DI float fast_sigmoid(float x) { return __builtin_amdgcn_rcpf(1.0f + __builtin_amdgcn_exp2f(-x * LOG2E)); }
DI float wave_sum(float v) {
#pragma unroll
    for (int o = 1; o < 64; o <<= 1) v += __shfl_xor(v, o);
    return v;
}

namespace pg8 {
constexpr int BM = 256, BK = 64, HALF = 128, HTB = HALF * BK * 2, STAGE_BYTES = 8 * HTB, NXCD = 8, WGM = 4;
DI int lds_byte(int r, int c) { const int st = (r >> 4) * 2 + (c >> 5), rr = r & 15, cc = c & 31, ob = rr * 64 + cc * 2; return st * 1024 + (ob ^ (((ob >> 9) & 1) << 5)); }
DI void stage_rc(int b, int& R, int& C) { const int st = b / 1024, sb = b % 1024, swz = sb ^ (((sb >> 9) & 1) << 5); R = (st >> 1) * 16 + swz / 64; C = (st & 1) * 32 + (swz % 64) / 2; }
DI int perm32(int rho) { const int n = rho >> 4, i = rho & 15; return 8 * (i >> 2) + 4 * n + (i & 3); }
struct Unit { int pm, pn; };
struct Gemm { const bf16_t* A; const bf16_t* Bt; int M, N, K; };
struct StaticOrder {
    int nM, nN, nwg, G, c;
    DI void init(int M_, int N_, int G_, int c_) { nM = M_ / BM; nN = N_ / BM; nwg = nM * nN; G = G_; c = c_; }
    DI bool next(int i, Unit& u) const {
        const long L = (long)i * G + c; if (L >= nwg) return false;
        int wgid = (int)L; { const int q = nwg / NXCD, r = nwg % NXCD, xcd = wgid % NXCD, off = wgid / NXCD; wgid = (xcd < r ? xcd * (q + 1) : r * (q + 1) + (xcd - r) * q) + off; }
        const int nig = WGM * nN, gid = wgid / nig, fm = gid * WGM, gsz = (nM - fm) < WGM ? (nM - fm) : WGM;
        u.pm = fm + ((wgid % nig) % gsz); u.pn = (wgid % nig) / gsz; return true;
    }
};
#ifndef MK_ALIGN
#define MK_ALIGN false
#endif
#ifndef MK_SP2
#define MK_SP2 true
#endif
template <class Epi, bool ALIGN_EPI = MK_ALIGN, bool SP2 = MK_SP2>
DI void gemm_phase(LAS unsigned char* lds, const Gemm g, const StaticOrder& S, const Epi& E) {
    const int tid = threadIdx.x, wid = __builtin_amdgcn_readfirstlane(tid >> 6), lane = tid & 63, wr = wid >> 2, wc = wid & 3, fr = lane & 15, fq = lane >> 4;
    const int K = g.K, nt = K / BK;
    unsigned voffA[2];
#pragma unroll
    for (int i = 0; i < 2; ++i) { int R, C; stage_rc(tid * 16 + i * 8192, R, C); voffA[i] = (unsigned)(R * K + C) * 2u; }
    const size_t kstep = (size_t)(BK * 2);
    const size_t hstep = (size_t)HALF * K * 2;
    const size_t tstep = 2 * hstep;
    const unsigned ldsw = (unsigned)wid * 1024u;
    const int aoff = lds_byte(wr * 64 + fr, fq * 8), boff = lds_byte(wc * 32 + fr, fq * 8);
#define PG8_SA(b, h) (((b) * 2 + (h)) * HTB)
#define PG8_SB(b, h) ((4 + (b) * 2 + (h)) * HTB)
#define PG8_STAGE(bufoff, gbase) do { _Pragma("unroll") for (int _i = 0; _i < 2; ++_i) \
        __builtin_amdgcn_global_load_lds((const unsigned*)((const char*)(gbase) + voffA[_i]), (LAS unsigned*)(lds + (bufoff) + ldsw + _i * 8192), 16, 0, 0); } while (0)
#define PG8_LDA(dst, b, h) do { _Pragma("unroll") for (int m = 0; m < 4; ++m) _Pragma("unroll") for (int k = 0; k < 2; ++k) dst[m][k] = *(const LAS bf16x8*)(lds + PG8_SA(b, h) + aoff + m * 2048 + k * 1024); } while (0)
#define PG8_LDB(dst, b, h) do { _Pragma("unroll") for (int n = 0; n < 2; ++n) _Pragma("unroll") for (int k = 0; k < 2; ++k) dst[n][k] = *(const LAS bf16x8*)(lds + PG8_SB(b, h) + boff + n * 2048 + k * 1024); } while (0)
#define PG8_MMA(ai, bj, At, Bt) do { __builtin_amdgcn_s_setprio(1); _Pragma("unroll") for (int m = 0; m < 4; ++m) _Pragma("unroll") for (int n = 0; n < 2; ++n) _Pragma("unroll") for (int k = 0; k < 2; ++k) \
        acc[ai][bj][m][n] = __builtin_amdgcn_mfma_f32_16x16x32_bf16(Bt[n][k], At[m][k], acc[ai][bj][m][n], 0, 0, 0); __builtin_amdgcn_s_setprio(0); } while (0)
#define PG8_WAIT_V(n) asm volatile("s_waitcnt vmcnt(" #n ")" ::: "memory")
#define PG8_WAIT_L(n) asm volatile("s_waitcnt lgkmcnt(" #n ")" ::: "memory")
#define PG8_BAR __builtin_amdgcn_s_barrier()
#define PG8_SCHED __builtin_amdgcn_sched_barrier(0)
    Unit cur, nxt; int ui = 0;
    if (!S.next(0, cur)) return;
    f32x4 acc[2][2][4][2];
#pragma unroll
    for (int a = 0; a < 2; ++a)
#pragma unroll
        for (int b = 0; b < 2; ++b)
#pragma unroll
            for (int m = 0; m < 4; ++m)
#pragma unroll
                for (int n = 0; n < 2; ++n) acc[a][b][m][n] = (f32x4){0.f, 0.f, 0.f, 0.f};
    bf16x8 At[4][2], B0[2][2], B1[2][2];
    const char* cA = (const char*)g.A + (size_t)cur.pm * tstep; const char* cB = (const char*)g.Bt + (size_t)cur.pn * tstep;
    if constexpr (SP2) {
        PG8_STAGE(PG8_SB(0, 0), cB); PG8_STAGE(PG8_SB(0, 1), cB + hstep); PG8_STAGE(PG8_SA(0, 0), cA); PG8_STAGE(PG8_SA(0, 1), cA + hstep);
        if (wr == 1) PG8_BAR;
        PG8_WAIT_V(2); PG8_BAR;
        PG8_STAGE(PG8_SB(1, 0), cB + kstep); PG8_STAGE(PG8_SA(1, 0), cA + kstep); PG8_STAGE(PG8_SB(1, 1), cB + hstep + kstep);
        PG8_WAIT_V(6); PG8_BAR;
    } else {
        PG8_STAGE(PG8_SB(0, 0), cB); PG8_STAGE(PG8_SA(0, 0), cA); PG8_STAGE(PG8_SB(0, 1), cB + hstep); PG8_STAGE(PG8_SA(0, 1), cA + hstep);
        if (wr == 1) PG8_BAR;
        PG8_WAIT_V(4); PG8_BAR;
        PG8_STAGE(PG8_SB(1, 0), cB + kstep); PG8_STAGE(PG8_SA(1, 0), cA + kstep); PG8_STAGE(PG8_SB(1, 1), cB + hstep + kstep);
        PG8_WAIT_V(6); PG8_BAR;
    }
    for (;;) {
        const bool has_next = S.next(ui + 1, nxt);
        const char* nA = has_next ? (const char*)g.A + (size_t)nxt.pm * tstep : cA; const char* nB = has_next ? (const char*)g.Bt + (size_t)nxt.pn * tstep : cB;
        for (int t = 0; t < nt; t += 2) {
            if constexpr (Epi::MIDK) { if (t == (nt >> 1)) E.mid(acc, cur, wr, wc, fr, fq); }
            const bool last = (t == nt - 2);
            const char* a1 = cA + (size_t)(t + 1) * kstep;
            const char* a2 = last ? nA : cA + (size_t)(t + 2) * kstep; const char* b2 = last ? nB : cB + (size_t)(t + 2) * kstep;
            const char* a3 = a2 + kstep; const char* b3 = b2 + kstep;
            if constexpr (SP2) {
            PG8_LDB(B0, 0, 0); PG8_LDB(B1, 0, 1); PG8_SCHED; PG8_LDA(At, 0, 0); PG8_STAGE(PG8_SA(1, 1), a1 + hstep);
            PG8_WAIT_V(8); PG8_WAIT_L(0); PG8_BAR; PG8_MMA(0, 0, At, B0); PG8_MMA(0, 1, At, B1); PG8_BAR; PG8_SCHED;
            PG8_LDA(At, 0, 1); PG8_STAGE(PG8_SB(0, 0), b2); PG8_STAGE(PG8_SB(0, 1), b2 + hstep); PG8_STAGE(PG8_SA(0, 0), a2);
            PG8_WAIT_V(8); PG8_WAIT_L(0); PG8_BAR; PG8_MMA(1, 0, At, B0); PG8_MMA(1, 1, At, B1); PG8_BAR; PG8_SCHED;
            PG8_LDB(B0, 1, 0); PG8_LDB(B1, 1, 1); PG8_SCHED; PG8_LDA(At, 1, 0); PG8_STAGE(PG8_SA(0, 1), a2 + hstep);
            PG8_WAIT_V(8); PG8_WAIT_L(0); PG8_BAR; PG8_MMA(0, 0, At, B0); PG8_MMA(0, 1, At, B1); PG8_BAR; PG8_SCHED;
            PG8_LDA(At, 1, 1); PG8_STAGE(PG8_SB(1, 0), b3); PG8_STAGE(PG8_SB(1, 1), b3 + hstep); PG8_STAGE(PG8_SA(1, 0), a3);
            PG8_WAIT_V(8); PG8_WAIT_L(0); PG8_BAR; PG8_MMA(1, 0, At, B0); PG8_MMA(1, 1, At, B1); PG8_BAR; PG8_SCHED;
            } else {
            PG8_LDB(B0, 0, 0); PG8_SCHED; PG8_LDA(At, 0, 0); PG8_STAGE(PG8_SA(1, 1), a1 + hstep);
            PG8_WAIT_L(8); PG8_BAR; PG8_WAIT_L(0); PG8_MMA(0, 0, At, B0); PG8_BAR; PG8_SCHED;
            PG8_LDB(B1, 0, 1); PG8_STAGE(PG8_SB(0, 0), b2);
            PG8_BAR; PG8_WAIT_L(0); PG8_MMA(0, 1, At, B1); PG8_BAR;
            PG8_LDA(At, 0, 1); PG8_STAGE(PG8_SA(0, 0), a2);
            PG8_BAR; PG8_WAIT_L(0); PG8_MMA(1, 0, At, B0); PG8_BAR; PG8_SCHED;
            PG8_STAGE(PG8_SB(0, 1), b2 + hstep);
            PG8_WAIT_V(6); PG8_BAR; PG8_MMA(1, 1, At, B1); PG8_BAR;
            PG8_LDB(B0, 1, 0); PG8_SCHED; PG8_LDA(At, 1, 0); PG8_STAGE(PG8_SA(0, 1), a2 + hstep);
            PG8_WAIT_L(8); PG8_BAR; PG8_WAIT_L(0); PG8_MMA(0, 0, At, B0); PG8_BAR; PG8_SCHED;
            PG8_LDB(B1, 1, 1); PG8_STAGE(PG8_SB(1, 0), b3);
            PG8_BAR; PG8_WAIT_L(0); PG8_MMA(0, 1, At, B1); PG8_BAR;
            PG8_LDA(At, 1, 1); PG8_STAGE(PG8_SA(1, 0), a3);
            PG8_BAR; PG8_WAIT_L(0); PG8_MMA(1, 0, At, B0); PG8_BAR; PG8_SCHED;
            PG8_STAGE(PG8_SB(1, 1), b3 + hstep);
            PG8_WAIT_V(6); PG8_BAR; PG8_MMA(1, 1, At, B1); PG8_BAR;
            }
        }
        if constexpr (ALIGN_EPI) { if (wr == 0) PG8_BAR; }
        E(acc, cur, wr, wc, fr, fq);
        if (!has_next) break;
#pragma unroll
        for (int a = 0; a < 2; ++a)
#pragma unroll
            for (int b = 0; b < 2; ++b)
#pragma unroll
                for (int m = 0; m < 4; ++m)
#pragma unroll
                    for (int n = 0; n < 2; ++n) acc[a][b][m][n] = (f32x4){0.f, 0.f, 0.f, 0.f};
        cur = nxt; cA = nA; cB = nB; ++ui;
        if constexpr (ALIGN_EPI) { if (wr == 1) PG8_BAR; }
    }
    PG8_WAIT_V(0);
    if constexpr (!ALIGN_EPI) { if (wr == 0) PG8_BAR; }
    PG8_BAR;
#undef PG8_SA
#undef PG8_SB
#undef PG8_STAGE
#undef PG8_LDA
#undef PG8_LDB
#undef PG8_MMA
#undef PG8_WAIT_V
#undef PG8_WAIT_L
#undef PG8_BAR
#undef PG8_SCHED
}
}
using pg8::Unit;
typedef f32x4 AccT[2][2][4][2];

struct EpiIn {
    static constexpr bool MIDK = false;
    bf16_t *U, *QKV, *RATIO, *SGA; float* KN;
    DI void mid(AccT&, const Unit&, int, int, int, int) const {}
    DI void operator()(const AccT& acc, const Unit& u, int wr, int wc, int fr, int fq) const {
        const int row0 = u.pm * 256 + wr * 64 + fr;
        if (u.pn < 4) {
#pragma unroll
            for (int ai = 0; ai < 2; ++ai)
#pragma unroll
                for (int m = 0; m < 4; ++m) { const size_t row = (size_t)(row0 + ai * 128 + m * 16); const int ch0 = u.pn * 128 + wc * 32 + fq * 8; float o[8];
#pragma unroll
                    for (int n = 0; n < 2; ++n) { const f32x4 a = acc[ai][0][m][n], gt = acc[ai][1][m][n];
#pragma unroll
                        for (int j = 0; j < 4; ++j) o[4 * n + j] = a[j] * fast_sigmoid(gt[j]); }
                    u32x4 w; w.x = pk2(o[0], o[1]); w.y = pk2(o[2], o[3]); w.z = pk2(o[4], o[5]); w.w = pk2(o[6], o[7]);
                    *(u32x4*)(U + row * CW + ch0) = w; }
        } else if (u.pn < 10) {
            const float sc = (u.pn < 6) ? (0.125f * LOG2E) : 1.0f;
#pragma unroll
            for (int ai = 0; ai < 2; ++ai)
#pragma unroll
                for (int m = 0; m < 4; ++m) { const size_t row = (size_t)(row0 + ai * 128 + m * 16);
#pragma unroll
                    for (int bj = 0; bj < 2; ++bj) { const int col0 = (u.pn - 4) * 256 + bj * 128 + wc * 32 + fq * 8;
                        const f32x4 v0 = acc[ai][bj][m][0] * sc, v1 = acc[ai][bj][m][1] * sc;
                        u32x4 w; w.x = pk2(v0[0], v0[1]); w.y = pk2(v0[2], v0[3]); w.z = pk2(v1[0], v1[1]); w.w = pk2(v1[2], v1[3]);
                        *(u32x4*)(QKV + row * 1536 + col0) = w; } }
            if (u.pn == 6 || u.pn == 7) {
#pragma unroll
                for (int ai = 0; ai < 2; ++ai)
#pragma unroll
                    for (int bj = 0; bj < 2; ++bj) { float mx = 0.f;
#pragma unroll
                        for (int m = 0; m < 4; ++m) { const f32x4 v0 = acc[ai][bj][m][0], v1 = acc[ai][bj][m][1]; float q = 0.f;
#pragma unroll
                            for (int j = 0; j < 4; ++j) { const float a = bf_lo(pk2(v0[j], 0.f)), c = bf_lo(pk2(v1[j], 0.f)); q += a * a + c * c; }
                            q += __shfl_xor(q, 16); q += __shfl_xor(q, 32); mx = fmaxf(mx, q); }
#pragma unroll
                        for (int o = 1; o < 16; o <<= 1) mx = fmaxf(mx, __shfl_xor(mx, o));
                        const int rowb = u.pm * 256 + ai * 128 + wr * 64, hh = (u.pn - 6) * 4 + bj * 2 + (wc >> 1);
                        if ((fr | fq) == 0) KN[((size_t)(((rowb >> 12) * 8 + hh) * 64 + ((rowb & 4095) >> 6))) * 2 + (wc & 1)] = mx; }
            }
        } else {
#pragma unroll
            for (int ai = 0; ai < 2; ++ai)
#pragma unroll
                for (int m = 0; m < 4; ++m) { const size_t row = (size_t)(row0 + ai * 128 + m * 16); const int ch0 = (u.pn - 10) * 128 + wc * 32 + fq * 8; float r[8], s[8];
#pragma unroll
                    for (int n = 0; n < 2; ++n) { const f32x4 gc = acc[ai][0][m][n], ga = acc[ai][1][m][n];
#pragma unroll
                        for (int j = 0; j < 4; ++j) { const float ea = 1.0f + __builtin_amdgcn_exp2f(-fmaxf(ga[j], -80.f) * LOG2E);
                            s[4 * n + j] = __builtin_amdgcn_rcpf(ea); r[4 * n + j] = fast_sigmoid(gc[j]) * ea; } }
                    u32x4 wr_, ws_; wr_.x = pk2(r[0], r[1]); wr_.y = pk2(r[2], r[3]); wr_.z = pk2(r[4], r[5]); wr_.w = pk2(r[6], r[7]);
                    ws_.x = pk2(s[0], s[1]); ws_.y = pk2(s[2], s[3]); ws_.z = pk2(s[4], s[5]); ws_.w = pk2(s[6], s[7]);
                    *(u32x4*)(RATIO + row * D + ch0) = wr_; *(u32x4*)(SGA + row * D + ch0) = ws_; }
        }
    }
};
struct EpiMix {
    static constexpr bool MIDK = true;
    const bf16_t *RATIO, *SGA; bf16_t* O;
    DI void scale(AccT& acc, const bf16_t* T, const Unit& u, int wr, int wc, int fr, int fq) const {
        int row0 = u.pm * 256 + wr * 64 + fr; asm volatile("" : "+v"(row0));
        const bf16_t* Tp = T + (size_t)row0 * D + u.pn * 256 + wc * 32 + fq * 8;
#pragma unroll
        for (int ai = 0; ai < 2; ++ai)
#pragma unroll
            for (int m = 0; m < 4; ++m) {
#pragma unroll
                for (int bj = 0; bj < 2; ++bj) {
                    const u32x4 w = *(const u32x4*)(Tp + (ai * 128 + m * 16) * D + bj * 128);
                    acc[ai][bj][m][0] *= (f32x4){bf_lo(w.x), bf_hi(w.x), bf_lo(w.y), bf_hi(w.y)};
                    acc[ai][bj][m][1] *= (f32x4){bf_lo(w.z), bf_hi(w.z), bf_lo(w.w), bf_hi(w.w)}; } }
    }
    DI void mid(AccT& acc, const Unit& u, int wr, int wc, int fr, int fq) const { scale(acc, RATIO, u, wr, wc, fr, fq); }
    DI void operator()(AccT& acc, const Unit& u, int wr, int wc, int fr, int fq) const {
        scale(acc, SGA, u, wr, wc, fr, fq);
        const int row0 = u.pm * 256 + wr * 64 + fr;
#pragma unroll
        for (int ai = 0; ai < 2; ++ai)
#pragma unroll
            for (int m = 0; m < 4; ++m) { const size_t row = (size_t)(row0 + ai * 128 + m * 16);
#pragma unroll
                for (int bj = 0; bj < 2; ++bj) { const int col0 = u.pn * 256 + bj * 128 + wc * 32 + fq * 8;
                    const f32x4 v0 = acc[ai][bj][m][0], v1 = acc[ai][bj][m][1];
                    u32x4 w; w.x = pk2(v0[0], v0[1]); w.y = pk2(v0[2], v0[3]); w.z = pk2(v1[0], v1[1]); w.w = pk2(v1[2], v1[3]);
                    *(u32x4*)(O + row * D + col0) = w; } }
    }
};
struct EpiY {
    static constexpr bool MIDK = false;
    bf16_t* Y; float* ss;
    DI void mid(AccT&, const Unit&, int, int, int, int) const {}
    DI void operator()(const AccT& acc, const Unit& u, int wr, int wc, int fr, int fq) const {
        const int row0 = u.pm * 256 + wr * 64 + fr;
#pragma unroll
        for (int ai = 0; ai < 2; ++ai)
#pragma unroll
            for (int m = 0; m < 4; ++m) { const size_t row = (size_t)(row0 + ai * 128 + m * 16); float q = 0.f;
#pragma unroll
                for (int bj = 0; bj < 2; ++bj) { const int col0 = u.pn * 256 + bj * 128 + wc * 32 + fq * 8;
                    const f32x4 v0 = acc[ai][bj][m][0], v1 = acc[ai][bj][m][1];
                    q += (v0[0] * v0[0] + v0[1] * v0[1]) + (v0[2] * v0[2] + v0[3] * v0[3]) + (v1[0] * v1[0] + v1[1] * v1[1]) + (v1[2] * v1[2] + v1[3] * v1[3]);
                    u32x4 w; w.x = pk2(v0[0], v0[1]); w.y = pk2(v0[2], v0[3]); w.z = pk2(v1[0], v1[1]); w.w = pk2(v1[2], v1[3]);
                    *(u32x4*)(Y + row * D + col0) = w; }
                q += __shfl_xor(q, 16); q += __shfl_xor(q, 32);
                if (fq == 0) ss[row * 16 + u.pn * 4 + wc] = q; }
    }
};
struct EpiF1 {
    static constexpr bool MIDK = false;
    bf16_t* HID;
    DI void mid(AccT&, const Unit&, int, int, int, int) const {}
    DI void operator()(const AccT& acc, const Unit& u, int wr, int wc, int fr, int fq) const {
        const int row0 = u.pm * 256 + wr * 64 + fr;
#pragma unroll
        for (int ai = 0; ai < 2; ++ai)
#pragma unroll
            for (int m = 0; m < 4; ++m) { const size_t row = (size_t)(row0 + ai * 128 + m * 16); const int ch0 = u.pn * 128 + wc * 32 + fq * 8; float o[8];
#pragma unroll
                for (int n = 0; n < 2; ++n) { const f32x4 gt = acc[ai][0][m][n], up = acc[ai][1][m][n];
#pragma unroll
                    for (int j = 0; j < 4; ++j) o[4 * n + j] = gt[j] * fast_sigmoid(gt[j]) * up[j]; }
                u32x4 w; w.x = pk2(o[0], o[1]); w.y = pk2(o[2], o[3]); w.z = pk2(o[4], o[5]); w.w = pk2(o[6], o[7]);
                *(u32x4*)(HID + row * DFF + ch0) = w; }
    }
};

DI int src_pair(int np, int second_off) { const int pn = np >> 8, tc = np & 255, bj = tc >> 7, wc = (tc >> 5) & 3; return pn * 128 + wc * 32 + pg8::perm32(tc & 31) + bj * second_off; }
DI int src_nat(int np) { return (np & ~31) + pg8::perm32(np & 31); }
DI void tr_item(const float* W, int ldw, bf16_t* WT, int Kd, int kdst0, int ksrc0, int n0, int srccol, LAS float* scr, int lane) {
    const int g4 = lane & 7, kr = lane >> 3;
    const float* src = W + (size_t)ksrc0 * ldw + __shfl(srccol, 4 * g4);
    f32x4 tv[8];
#pragma unroll
    for (int i = 0; i < 8; ++i) tv[i] = *(const f32x4*)(src + (size_t)(8 * i + kr) * ldw);
#pragma unroll
    for (int i = 0; i < 8; ++i) { LAS float* d = scr + (8 * i + kr) * 33 + 4 * g4; d[0] = tv[i].x; d[1] = tv[i].y; d[2] = tv[i].z; d[3] = tv[i].w; }
    asm volatile("s_waitcnt lgkmcnt(0)" ::: "memory");
    const int c = lane & 7;
#pragma unroll
    for (int j = 0; j < 4; ++j) { const int n = (lane >> 3) + 8 * j; const LAS float* s = scr + (8 * c) * 33 + n;
        u32x4 o; o.x = pk2(s[0 * 33], s[1 * 33]); o.y = pk2(s[2 * 33], s[3 * 33]); o.z = pk2(s[4 * 33], s[5 * 33]); o.w = pk2(s[6 * 33], s[7 * 33]);
        *(u32x4*)(WT + (size_t)(n0 + n) * Kd + kdst0 + 8 * c) = o; }
    asm volatile("s_waitcnt lgkmcnt(0)" ::: "memory");
}
constexpr int TR_IN = 16 * 144, TR_MIX = 16 * 32, TR_O = 16 * 32, TR_F1 = 16 * 176, TR_F2 = 44 * 32, TR_LAYER = TR_IN + TR_MIX + TR_O + TR_F1 + TR_F2;
constexpr int MOD_ITEMS = 2 * 96 * 4;
DI void phase0(const Params& p, LAS unsigned char* lds) {
    const int lane = threadIdx.x & 63, wave = threadIdx.x >> 6;
    LAS float* scr = (LAS float*)(lds + wave * 16384);
    const int gw = blockIdx.x * 8 + wave, NGW = gridDim.x * 8;
    for (int q = blockIdx.x; q < 192; q += gridDim.x) {
        const int kc = wave, l = q / 96, col = (q % 96) * 64 + lane;
        const float* W = p.ada_w + (size_t)l * D * 6144 + col;
        float acc[16];
#pragma unroll
        for (int b = 0; b < 16; ++b) acc[b] = 0.f;
        for (int k0 = kc * 128; k0 < kc * 128 + 128; k0 += 16) {
            float w[16], sv[4];
#pragma unroll
            for (int kq = 0; kq < 16; ++kq) w[kq] = W[(size_t)(k0 + kq) * 6144];
#pragma unroll
            for (int g = 0; g < 4; ++g) { const float cv = p.c[(lane & 15) * D + k0 + 4 * g + (lane >> 4)]; sv[g] = cv * fast_sigmoid(cv); }
#pragma unroll
            for (int kq = 0; kq < 16; ++kq)
#pragma unroll
                for (int b = 0; b < 16; ++b) acc[b] += __uint_as_float(__builtin_amdgcn_readlane(__float_as_uint(sv[kq >> 2]), b + 16 * (kq & 3))) * w[kq];
        }
        LAS float* part = (LAS float*)lds;
#pragma unroll
        for (int b = 0; b < 16; ++b) part[(wave * 16 + b) * 64 + lane] = acc[b];
        __syncthreads();
        if (wave < 2) { float* mo = (float*)(p.ws + OFF_MOD) + (size_t)l * NB * 6144 + col; const float bias = p.ada_b[l * 6144 + col];
#pragma unroll
            for (int bb = 0; bb < 8; ++bb) { const int b = wave * 8 + bb; float t = 0.f;
#pragma unroll
                for (int w8 = 0; w8 < 8; ++w8) t += part[(w8 * 16 + b) * 64 + lane];
                mo[b * 6144] = t + bias; } }
        __syncthreads();
    }
    for (int it = gw + MOD_ITEMS; it < MOD_ITEMS + 2 * TR_LAYER; it += NGW) {
        {
            int r = it - MOD_ITEMS; const int l = r / TR_LAYER; r -= l * TR_LAYER;
            if (r < TR_IN) { const int kb = r / 144, nb = r % 144, n0 = nb * 32, np = n0 + (lane & 31);
                const int sc = np < 1024 ? src_pair(np, 512) : (np < 2560 ? src_nat(np) : 2560 + src_pair(np - 2560, 1024));
                tr_item(p.w_in + (size_t)l * D * INC, INC, (bf16_t*)(p.ws + OFF_WIN) + (size_t)l * INC * D, D, kb * 64, kb * 64, n0, sc, scr, lane); continue; }
            r -= TR_IN;
            if (r < TR_MIX) { const int kb = r / 32, nb = r % 32, n0 = nb * 32, sc = src_nat(n0 + (lane & 31));
                const float* W = kb < 8 ? p.w_conv_out + (size_t)l * CW * D : p.w_att_out + (size_t)l * CW * D;
                tr_item(W, D, (bf16_t*)(p.ws + OFF_WMIX) + (size_t)l * D * D, D, kb * 64, (kb & 7) * 64, n0, sc, scr, lane); continue; }
            r -= TR_MIX;
            if (r < TR_O) { const int kb = r / 32, nb = r % 32, n0 = nb * 32, sc = src_nat(n0 + (lane & 31));
                tr_item(p.w_o + (size_t)l * D * D, D, (bf16_t*)(p.ws + OFF_WO) + (size_t)l * D * D, D, kb * 64, kb * 64, n0, sc, scr, lane); continue; }
            r -= TR_O;
            if (r < TR_F1) { const int kb = r / 176, nb = r % 176, n0 = nb * 32, sc = src_pair(n0 + (lane & 31), DFF);
                tr_item(p.w_ffn_in + (size_t)l * D * 2 * DFF, 2 * DFF, (bf16_t*)(p.ws + OFF_WF1) + (size_t)l * 2 * DFF * D, D, kb * 64, kb * 64, n0, sc, scr, lane); continue; }
            r -= TR_F1;
            { const int kb = r / 32, nb = r % 32, n0 = nb * 32, sc = src_nat(n0 + (lane & 31));
                tr_item(p.w_ffn_out + (size_t)l * DFF * D, D, (bf16_t*)(p.ws + OFF_WF2) + (size_t)l * D * DFF, DFF, kb * 64, kb * 64, n0, sc, scr, lane); }
        }
    }
}

DI void rowpass(const float* xin, const bf16_t* xinb, const bf16_t* y, const float* ss, const float* gate, const float* postg, float* xout, bf16_t* xoutb,
                const float* gnext, const float* scn, const float* shn, bf16_t* hout) {
    const int lane = threadIdx.x & 63, wave = threadIdx.x >> 6;
    const int gw = blockIdx.x * 8 + wave, NGW = gridDim.x * 8;
    constexpr int NR = 4, RPW = 32;
    for (int base = gw * RPW; base < M; base += NGW * RPW) {
        const int b = base >> 12;
        f32x4 c1[4], c2[4], c3[4];
#pragma unroll
        for (int j = 0; j < 4; ++j) { const int col = 4 * lane + 256 * j;
            c1[j] = y ? *(const f32x4*)(gate + b * 6144 + col) * *(const f32x4*)(postg + col) : (f32x4){0.f, 0.f, 0.f, 0.f};
            if (gnext) { c2[j] = *(const f32x4*)(gnext + col) * (1.0f + *(const f32x4*)(scn + b * 6144 + col)); c3[j] = *(const f32x4*)(shn + b * 6144 + col); }
            else { c2[j] = (f32x4){0.f, 0.f, 0.f, 0.f}; c3[j] = c2[j]; } }
        for (int r0 = 0; r0 < RPW; r0 += NR) {
            f32x4 v[NR][4]; u32x2 yw[NR][4]; float sq[NR];
#pragma unroll
            for (int q = 0; q < NR; ++q) { const size_t row = (size_t)(base + r0 + q);
#pragma unroll
                for (int j = 0; j < 4; ++j) {
                    if (xinb) { const u32x2 w = *(const u32x2*)(xinb + row * D + 4 * lane + 256 * j); v[q][j] = (f32x4){bf_lo(w.x), bf_hi(w.x), bf_lo(w.y), bf_hi(w.y)}; }
                    else v[q][j] = *(const f32x4*)(xin + row * D + 4 * lane + 256 * j); }
                if (y) { sq[q] = lane < 16 ? ss[row * 16 + lane] : 0.f;
#pragma unroll
                    for (int j = 0; j < 4; ++j) yw[q][j] = *(const u32x2*)(y + row * D + 4 * lane + 256 * j); } }
#pragma unroll
            for (int q = 0; q < NR; ++q) { const size_t row = (size_t)(base + r0 + q);
                if (y) {
                    const float rs = __builtin_amdgcn_rsqf(wave_sum(sq[q]) * (1.0f / D) + EPS);
#pragma unroll
                    for (int j = 0; j < 4; ++j) { const int col = 4 * lane + 256 * j; const u32x2 w = yw[q][j];
                        const f32x4 yv = {bf_lo(w.x), bf_hi(w.x), bf_lo(w.y), bf_hi(w.y)};
                        v[q][j] += (yv * rs) * c1[j];
                        if (xoutb) { u32x2 wo; wo.x = pk2(v[q][j].x, v[q][j].y); wo.y = pk2(v[q][j].z, v[q][j].w); *(u32x2*)(xoutb + row * D + col) = wo; }
                        else *(f32x4*)(xout + row * D + col) = v[q][j]; }
                }
                if (gnext) {
                    float s = 0.f;
#pragma unroll
                    for (int j = 0; j < 4; ++j) s += (v[q][j].x * v[q][j].x + v[q][j].y * v[q][j].y) + (v[q][j].z * v[q][j].z + v[q][j].w * v[q][j].w);
                    const float r = __builtin_amdgcn_rsqf(wave_sum(s) * (1.0f / D) + EPS);
#pragma unroll
                    for (int j = 0; j < 4; ++j) { const int col = 4 * lane + 256 * j;
                        const f32x4 hv = (v[q][j] * r) * c2[j] + c3[j];
                        u32x2 w; w.x = pk2(hv.x, hv.y); w.y = pk2(hv.z, hv.w);
                        *(u32x2*)(hout + row * D + col) = w; }
                }
            }
        }
    }
}

DI int crow(int r, int hi) { return (r & 3) + 8 * (r >> 2) + 4 * hi; }
#define MFMA32(a, b, c) __builtin_amdgcn_mfma_f32_32x32x16_bf16((a), (b), (c), 0, 0, 0)
typedef short v4i16_t __attribute__((ext_vector_type(4)));
DI s16x4 vtr(const LAS unsigned char* p) { return __builtin_bit_cast(s16x4, __builtin_amdgcn_ds_read_tr16_b64_v4i16((LAS v4i16_t*)p)); }
DI float softplus2(float z) {
    return fmaxf(z, 0.f) + __builtin_amdgcn_logf(1.0f + __builtin_amdgcn_exp2f(-fabsf(z)));
}
constexpr int KPITCH = 144, KVBUF = 64 * KPITCH;
DI void attn_wave(const bf16_t* QKV, const float* knp, bf16_t* OUT, LAS unsigned char* vl, int bh, int qb) {
    const int lane = threadIdx.x & 63, r32 = lane & 31, hi = lane >> 5;
    const int b = bh >> 3, h = bh & 7; const size_t rowbase = (size_t)b * SEQ;
    const int wq0 = qb * 32, tq = wq0 + r32;
    bf16x8 qf[4];
    { const bf16_t* qp = QKV + (rowbase + tq) * 1536 + h * 64 + hi * 8;
#pragma unroll
      for (int d0 = 0; d0 < 4; ++d0) qf[d0] = *(const bf16x8*)(qp + d0 * 16); }
    float qn;
    { float s = 0.f;
#pragma unroll
      for (int d0 = 0; d0 < 4; ++d0) { const u32x4 w = __builtin_bit_cast(u32x4, qf[d0]);
          s += bf_lo(w.x) * bf_lo(w.x) + bf_hi(w.x) * bf_hi(w.x) + bf_lo(w.y) * bf_lo(w.y) + bf_hi(w.y) * bf_hi(w.y) + bf_lo(w.z) * bf_lo(w.z) + bf_hi(w.z) * bf_hi(w.z) + bf_lo(w.w) * bf_lo(w.w) + bf_hi(w.w) * bf_hi(w.w); }
      auto rr = __builtin_amdgcn_permlane32_swap(__float_as_uint(s), __float_as_uint(s), false, false);
      qn = sqrtf(__uint_as_float(rr[0]) + __uint_as_float(rr[1])) * 1.001f; }
    float knpref;
    { const f32x2 kp = *(const f32x2*)(knp + ((size_t)bh * 64 + lane) * 2); float v = sqrtf(kp.x + kp.y) * 1.001f;
#pragma unroll
      for (int o = 1; o < 64; o <<= 1) { const float t = __shfl_up(v, o); if (lane >= o) v = fmaxf(v, t); }
      knpref = v; }
    f32x16 o0, o1;
#pragma unroll
    for (int i = 0; i < 16; ++i) { o0[i] = 0.f; o1[i] = 0.f; }
    float R = 0.f;
    int kb = (wq0 + 31) >> 6;
    const bf16_t* kbase = QKV + rowbase * 1536 + 512 + h * 64;
    bf16x8 ka[4], kc[4];
    { const bf16_t* kp = kbase + (size_t)(kb * 64 + r32) * 1536 + hi * 8;
#pragma unroll
      for (int d0 = 0; d0 < 4; ++d0) { ka[d0] = *(const bf16x8*)(kp + d0 * 16); kc[d0] = *(const bf16x8*)(kp + 32 * 1536 + d0 * 16); } }
    const int vq = (lane & 15) >> 2, vp = lane & 3, vblk = (lane >> 4) & 1;
    const unsigned vlane = (4 * hi + vq) * KPITCH + vblk * 32 + vp * 8;
    const unsigned vst = (lane >> 3) * KPITCH + (lane & 7) * 16;
    const float lomask = hi ? 0.f : 1.f;
    for (;;) {
        const int s0 = kb * 64;
        u32x4 vr[8];
        { const bf16_t* vp_ = kbase + 512 + (size_t)(s0 + (lane >> 3)) * 1536 + (lane & 7) * 8;
#pragma unroll
          for (int i = 0; i < 8; ++i) vr[i] = *(const u32x4*)(vp_ + (size_t)(8 * i) * 1536); }
        f32x16 z0, z1;
#pragma unroll
        for (int i = 0; i < 16; ++i) { z0[i] = 0.f; z1[i] = 0.f; }
#pragma unroll
        for (int d0 = 0; d0 < 4; ++d0) { z0 = MFMA32(ka[d0], qf[d0], z0); z1 = MFMA32(kc[d0], qf[d0], z1); }
        if (kb > 0) { const bf16_t* kp = kbase + (size_t)((kb - 1) * 64 + r32) * 1536 + hi * 8;
#pragma unroll
            for (int d0 = 0; d0 < 4; ++d0) { ka[d0] = *(const bf16x8*)(kp + d0 * 16); kc[d0] = *(const bf16x8*)(kp + 32 * 1536 + d0 * 16); } }
        if (s0 + 63 >= wq0) {
#pragma unroll
            for (int i = 0; i < 16; ++i) { const int kv = s0 + crow(i, hi); if (kv >= tq) z0[i] = -INFINITY; if (kv + 32 >= tq) z1[i] = -INFINITY; }
        }
        f32x16 c0, c1; float Glo[8], Ghi[8];
#pragma unroll
        for (int g = 0; g < 4; ++g) {
            float a3 = softplus2(z0[4 * g + 3]), a2 = softplus2(z0[4 * g + 2]) + a3, a1 = softplus2(z0[4 * g + 1]) + a2, a0 = softplus2(z0[4 * g]) + a1;
            c0[4 * g + 3] = a3; c0[4 * g + 2] = a2; c0[4 * g + 1] = a1; c0[4 * g] = a0;
            auto rr = __builtin_amdgcn_permlane32_swap(__float_as_uint(a0), __float_as_uint(a0), false, false);
            Glo[g] = __uint_as_float(rr[0]); Ghi[g] = __uint_as_float(rr[1]);
            float b3 = softplus2(z1[4 * g + 3]), b2 = softplus2(z1[4 * g + 2]) + b3, b1 = softplus2(z1[4 * g + 1]) + b2, b0 = softplus2(z1[4 * g]) + b1;
            c1[4 * g + 3] = b3; c1[4 * g + 2] = b2; c1[4 * g + 1] = b1; c1[4 * g] = b0;
            auto ss_ = __builtin_amdgcn_permlane32_swap(__float_as_uint(b0), __float_as_uint(b0), false, false);
            Glo[4 + g] = __uint_as_float(ss_[0]); Ghi[4 + g] = __uint_as_float(ss_[1]);
        }
        float run = R;
        u32x4 pf[2][2];
#pragma unroll
        for (int c = 7; c >= 0; --c) {
            const float base = __builtin_fmaf(Ghi[c], lomask, run);
            const int g = c & 3;
            float a[4];
            if (c >= 4) {
#pragma unroll
                for (int j = 0; j < 4; ++j) a[j] = __builtin_amdgcn_exp2f(z1[4 * g + j] - (c1[4 * g + j] + base));
                if (g & 1) { pf[1][g >> 1].z = pk2(a[0], a[1]); pf[1][g >> 1].w = pk2(a[2], a[3]); } else { pf[1][g >> 1].x = pk2(a[0], a[1]); pf[1][g >> 1].y = pk2(a[2], a[3]); }
            } else {
#pragma unroll
                for (int j = 0; j < 4; ++j) a[j] = __builtin_amdgcn_exp2f(z0[4 * g + j] - (c0[4 * g + j] + base));
                if (g & 1) { pf[0][g >> 1].z = pk2(a[0], a[1]); pf[0][g >> 1].w = pk2(a[2], a[3]); } else { pf[0][g >> 1].x = pk2(a[0], a[1]); pf[0][g >> 1].y = pk2(a[2], a[3]); }
            }
            run += Glo[c] + Ghi[c];
        }
        R = run;
#pragma unroll
        for (int i = 0; i < 8; ++i) *(LAS u32x4*)(vl + vst + i * 8 * KPITCH) = vr[i];
#pragma unroll
        for (int kt = 0; kt < 2; ++kt)
#pragma unroll
            for (int s = 0; s < 2; ++s) {
                const LAS unsigned char* vb = vl + vlane + (32 * kt + 16 * s) * KPITCH;
                const s16x4 l0 = vtr(vb), h0 = vtr(vb + 8 * KPITCH), l1 = vtr(vb + 64), h1 = vtr(vb + 64 + 8 * KPITCH);
                const bf16x8 v0 = __builtin_shufflevector(l0, h0, 0, 1, 2, 3, 4, 5, 6, 7), v1 = __builtin_shufflevector(l1, h1, 0, 1, 2, 3, 4, 5, 6, 7);
                const bf16x8 pb = __builtin_bit_cast(bf16x8, pf[kt][s]);
                o0 = MFMA32(v0, pb, o0); o1 = MFMA32(v1, pb, o1);
            }
        if (kb == 0) break;
        const float kbound = __uint_as_float(__builtin_amdgcn_readlane(__float_as_uint(knpref), kb - 1));
        if (__all((R - qn * kbound) > 160.f)) break;
        --kb;
    }
    bf16_t* op = OUT + (rowbase + tq) * D + CW + h * 64 + 4 * hi;
#pragma unroll
    for (int g = 0; g < 4; ++g) {
        u32x2 w0, w1; w0.x = pk2(o0[4 * g], o0[4 * g + 1]); w0.y = pk2(o0[4 * g + 2], o0[4 * g + 3]); w1.x = pk2(o1[4 * g], o1[4 * g + 1]); w1.y = pk2(o1[4 * g + 2], o1[4 * g + 3]);
        *(u32x2*)(op + 8 * g) = w0; *(u32x2*)(op + 32 + 8 * g) = w1;
    }
}

constexpr int ATT_BUF = 4 * KVBUF;
DI void attn_block(const bf16_t* QKV, const float* knp, bf16_t* OUT, LAS unsigned char* lds, int b, int hp, int qt) {
    const int tid = threadIdx.x, lane = tid & 63, r32 = lane & 31, hi = lane >> 5; const int wid = __builtin_amdgcn_readfirstlane(tid >> 6);
    const int hsel = wid >> 2, h = 2 * hp + hsel, bh = b * 8 + h; const size_t rowbase = (size_t)b * SEQ;
    const int q0 = qt * 128, wq0 = q0 + (wid & 3) * 32, tq = wq0 + r32;
    bf16x8 qf[4];
    { const bf16_t* qp = QKV + (rowbase + tq) * 1536 + h * 64 + hi * 8;
#pragma unroll
      for (int d0 = 0; d0 < 4; ++d0) qf[d0] = *(const bf16x8*)(qp + d0 * 16); }
    float qn;
    { float s = 0.f;
#pragma unroll
      for (int d0 = 0; d0 < 4; ++d0) { const u32x4 w = __builtin_bit_cast(u32x4, qf[d0]);
          s += bf_lo(w.x) * bf_lo(w.x) + bf_hi(w.x) * bf_hi(w.x) + bf_lo(w.y) * bf_lo(w.y) + bf_hi(w.y) * bf_hi(w.y) + bf_lo(w.z) * bf_lo(w.z) + bf_hi(w.z) * bf_hi(w.z) + bf_lo(w.w) * bf_lo(w.w) + bf_hi(w.w) * bf_hi(w.w); }
      auto rr = __builtin_amdgcn_permlane32_swap(__float_as_uint(s), __float_as_uint(s), false, false);
      qn = sqrtf(__uint_as_float(rr[0]) + __uint_as_float(rr[1])) * 1.001f; }
    float knpref;
    { const f32x2 kp = *(const f32x2*)(knp + ((size_t)bh * 64 + lane) * 2); float v = sqrtf(kp.x + kp.y) * 1.001f;
#pragma unroll
      for (int o = 1; o < 64; o <<= 1) { const float t = __shfl_up(v, o); if (lane >= o) v = fmaxf(v, t); }
      knpref = v; }
    f32x16 o0, o1;
#pragma unroll
    for (int i = 0; i < 16; ++i) { o0[i] = 0.f; o1[i] = 0.f; }
    float R = 0.f;
    const int nkb = (q0 + 128) / 64;
    const int srow = tid >> 3, sch = tid & 7;
    const bf16_t* sg = QKV + (rowbase + srow) * 1536 + 512 + (2 * hp) * 64 + sch * 8;
    const unsigned soff = srow * KPITCH + sch * 16;
    LAS unsigned* fl = (LAS unsigned*)(lds + 2 * ATT_BUF);
    u32x4 st0, st1, st2, st3;
#define ATT_LOAD(kb_) do { const bf16_t* g_ = sg + (size_t)(kb_) * 64 * 1536; st0 = *(const u32x4*)g_; st1 = *(const u32x4*)(g_ + 512); st2 = *(const u32x4*)(g_ + 64); st3 = *(const u32x4*)(g_ + 576); } while (0)
#define ATT_STORE(buf_) do { LAS unsigned char* d_ = lds + (buf_) * ATT_BUF + soff; *(LAS u32x4*)d_ = st0; *(LAS u32x4*)(d_ + KVBUF) = st1; *(LAS u32x4*)(d_ + 2 * KVBUF) = st2; *(LAS u32x4*)(d_ + 3 * KVBUF) = st3; } while (0)
    ATT_LOAD(nkb - 1); ATT_STORE(0);
    __syncthreads();
    const int vq = (lane & 15) >> 2, vp = lane & 3, vblk = (lane >> 4) & 1;
    const unsigned vlane = (4 * hi + vq) * KPITCH + vblk * 32 + vp * 8;
    const float lomask = hi ? 0.f : 1.f;
    for (int it = 0; it < nkb; ++it) {
        const int kb = nkb - 1 - it, cur = it & 1, s0 = kb * 64;
        const bool more = (it + 1 < nkb);
        if (more) ATT_LOAD(kb - 1);
        if (s0 < wq0 + 32) {
            const LAS unsigned char* Kb = lds + cur * ATT_BUF + hsel * (2 * KVBUF); const LAS unsigned char* Vb = Kb + KVBUF;
            f32x16 z0, z1;
#pragma unroll
            for (int i = 0; i < 16; ++i) { z0[i] = 0.f; z1[i] = 0.f; }
#pragma unroll
            for (int d0 = 0; d0 < 4; ++d0) {
                const bf16x8 ka = *(const LAS bf16x8*)(Kb + r32 * KPITCH + d0 * 32 + hi * 16);
                const bf16x8 kc = *(const LAS bf16x8*)(Kb + (32 + r32) * KPITCH + d0 * 32 + hi * 16);
                z0 = MFMA32(ka, qf[d0], z0); z1 = MFMA32(kc, qf[d0], z1);
            }
            if (s0 + 63 >= wq0) {
#pragma unroll
                for (int i = 0; i < 16; ++i) { const int kv = s0 + crow(i, hi); if (kv >= tq) z0[i] = -INFINITY; if (kv + 32 >= tq) z1[i] = -INFINITY; }
            }
            f32x16 c0, c1; float Glo[8], Ghi[8];
#pragma unroll
            for (int g = 0; g < 4; ++g) {
                float a3 = softplus2(z0[4 * g + 3]), a2 = softplus2(z0[4 * g + 2]) + a3, a1 = softplus2(z0[4 * g + 1]) + a2, a0 = softplus2(z0[4 * g]) + a1;
                c0[4 * g + 3] = a3; c0[4 * g + 2] = a2; c0[4 * g + 1] = a1; c0[4 * g] = a0;
                auto rr = __builtin_amdgcn_permlane32_swap(__float_as_uint(a0), __float_as_uint(a0), false, false);
                Glo[g] = __uint_as_float(rr[0]); Ghi[g] = __uint_as_float(rr[1]);
                float b3 = softplus2(z1[4 * g + 3]), b2 = softplus2(z1[4 * g + 2]) + b3, b1 = softplus2(z1[4 * g + 1]) + b2, b0 = softplus2(z1[4 * g]) + b1;
                c1[4 * g + 3] = b3; c1[4 * g + 2] = b2; c1[4 * g + 1] = b1; c1[4 * g] = b0;
                auto ss_ = __builtin_amdgcn_permlane32_swap(__float_as_uint(b0), __float_as_uint(b0), false, false);
                Glo[4 + g] = __uint_as_float(ss_[0]); Ghi[4 + g] = __uint_as_float(ss_[1]);
            }
            float run = R;
            u32x4 pf[2][2];
#pragma unroll
            for (int c = 7; c >= 0; --c) {
                const float base = __builtin_fmaf(Ghi[c], lomask, run);
                const int g = c & 3;
                float a[4];
                if (c >= 4) {
#pragma unroll
                    for (int j = 0; j < 4; ++j) a[j] = __builtin_amdgcn_exp2f(z1[4 * g + j] - (c1[4 * g + j] + base));
                    if (g & 1) { pf[1][g >> 1].z = pk2(a[0], a[1]); pf[1][g >> 1].w = pk2(a[2], a[3]); } else { pf[1][g >> 1].x = pk2(a[0], a[1]); pf[1][g >> 1].y = pk2(a[2], a[3]); }
                } else {
#pragma unroll
                    for (int j = 0; j < 4; ++j) a[j] = __builtin_amdgcn_exp2f(z0[4 * g + j] - (c0[4 * g + j] + base));
                    if (g & 1) { pf[0][g >> 1].z = pk2(a[0], a[1]); pf[0][g >> 1].w = pk2(a[2], a[3]); } else { pf[0][g >> 1].x = pk2(a[0], a[1]); pf[0][g >> 1].y = pk2(a[2], a[3]); }
                }
                run += Glo[c] + Ghi[c];
            }
            R = run;
#pragma unroll
            for (int kt = 0; kt < 2; ++kt)
#pragma unroll
                for (int s = 0; s < 2; ++s) {
                    const LAS unsigned char* vb = Vb + vlane + (32 * kt + 16 * s) * KPITCH;
                    const s16x4 l0 = vtr(vb), h0 = vtr(vb + 8 * KPITCH), l1 = vtr(vb + 64), h1 = vtr(vb + 64 + 8 * KPITCH);
                    const bf16x8 v0 = __builtin_shufflevector(l0, h0, 0, 1, 2, 3, 4, 5, 6, 7), v1 = __builtin_shufflevector(l1, h1, 0, 1, 2, 3, 4, 5, 6, 7);
                    const bf16x8 pb = __builtin_bit_cast(bf16x8, pf[kt][s]);
                    o0 = MFMA32(v0, pb, o0); o1 = MFMA32(v1, pb, o1);
                }
        }
        if (more) { ATT_STORE(cur ^ 1);
            const float kbound = __uint_as_float(__builtin_amdgcn_readlane(__float_as_uint(knpref), kb - 1));
            const bool ldone = (R - qn * kbound) > 160.f;
            if (lane == 0) fl[cur * 8 + wid] = __all(ldone) ? 1u : 0u; }
        __syncthreads();
        if (more) { const u32x4 fa = *(const LAS u32x4*)(fl + cur * 8), fb = *(const LAS u32x4*)(fl + cur * 8 + 4);
            if ((fa.x & fa.y & fa.z & fa.w & fb.x & fb.y & fb.z & fb.w) != 0u) break; }
    }
    __syncthreads();
#undef ATT_LOAD
#undef ATT_STORE
    bf16_t* op = OUT + (rowbase + tq) * D + CW + h * 64 + 4 * hi;
#pragma unroll
    for (int g = 0; g < 4; ++g) {
        u32x2 w0, w1; w0.x = pk2(o0[4 * g], o0[4 * g + 1]); w0.y = pk2(o0[4 * g + 2], o0[4 * g + 3]); w1.x = pk2(o1[4 * g], o1[4 * g + 1]); w1.y = pk2(o1[4 * g + 2], o1[4 * g + 3]);
        *(u32x2*)(op + 8 * g) = w0; *(u32x2*)(op + 32 + 8 * g) = w1;
    }
}

constexpr int CT = 64, CROWS = 96, CW_OFF = CROWS * 1024, CWROWS = 36;
DI void conv_load_w(const float* cw, LAS unsigned char* lds) {
    f32x2 wv[CWROWS * CW / 2 / 512];
#pragma unroll
    for (int k = 0; k < CWROWS * CW / 2 / 512; ++k) { const int i = threadIdx.x + 512 * k; wv[k] = (f32x2){0.f, 0.f}; if (i < CK * CW / 2) wv[k] = *(const f32x2*)(cw + 2 * i); }
#pragma unroll
    for (int k = 0; k < CWROWS * CW / 2 / 512; ++k) { const int i = threadIdx.x + 512 * k; *(LAS unsigned*)(lds + CW_OFF + 4 * i) = pk2(wv[k].x, wv[k].y); }
}
DI void unpack8(const u32x4 w, f32x2 (&o)[4]) { o[0] = (f32x2){bf_lo(w.x), bf_hi(w.x)}; o[1] = (f32x2){bf_lo(w.y), bf_hi(w.y)}; o[2] = (f32x2){bf_lo(w.z), bf_hi(w.z)}; o[3] = (f32x2){bf_lo(w.w), bf_hi(w.w)}; }
DI void conv_item(const bf16_t* U, bf16_t* OUT, const float* cb, const float* lg, const float* lb, LAS unsigned char* lds, int item) {
    const int tid = threadIdx.x, lane = tid & 63, wave = tid >> 6;
    const int b = item >> 6, t0 = (item & 63) * CT; const size_t rowbase = (size_t)b * SEQ;
    __syncthreads();
    { u32x4 tv[CROWS * 64 / 512];
#pragma unroll
      for (int k = 0; k < CROWS * 64 / 512; ++k) { const int i = tid + 512 * k, r = i >> 6, c16 = i & 63, s = t0 - (CK - 1) + r;
          tv[k] = (u32x4){0u, 0u, 0u, 0u}; if (s >= 0 && r < CT + CK - 1) tv[k] = *(const u32x4*)(U + (rowbase + s) * CW + c16 * 8); }
#pragma unroll
      for (int k = 0; k < CROWS * 64 / 512; ++k) { const int i = tid + 512 * k; *(LAS u32x4*)(lds + (i >> 6) * 1024 + (i & 63) * 16) = tv[k]; } }
    __syncthreads();
    f32x2 bias[4], g8[4], b8[4];
#pragma unroll
    for (int j = 0; j < 4; ++j) { bias[j] = *(const f32x2*)(cb + lane * 8 + 2 * j); g8[j] = *(const f32x2*)(lg + lane * 8 + 2 * j); b8[j] = *(const f32x2*)(lb + lane * 8 + 2 * j); }
    for (int grp = 0; grp < 2; ++grp) {
        const int t4 = wave * 8 + grp * 4;
        f32x2 acc[4][4], wv[4][4];
#pragma unroll
        for (int i = 0; i < 4; ++i)
#pragma unroll
            for (int j = 0; j < 4; ++j) { acc[i][j] = bias[j]; wv[i][j] = (f32x2){0.f, 0.f}; }
#pragma unroll 1
        for (int rb = 0; rb < CWROWS; rb += 4) {
#pragma unroll
            for (int q = 0; q < 4; ++q) {
                f32x2 u8[4]; unpack8(*(const LAS u32x4*)(lds + (t4 + rb + q) * 1024 + lane * 16), u8);
                unpack8(*(const LAS u32x4*)(lds + CW_OFF + (rb + q) * 1024 + lane * 16), wv[q]);
#pragma unroll
                for (int i = 0; i < 4; ++i)
#pragma unroll
                    for (int j = 0; j < 4; ++j) acc[i][j] = acc[i][j] + wv[(q - i) & 3][j] * u8[j];
            }
        }
#pragma unroll
        for (int i = 0; i < 4; ++i) {
            float s = 0.f;
#pragma unroll
            for (int j = 0; j < 4; ++j) s += acc[i][j].x + acc[i][j].y;
            const float mean = wave_sum(s) * (1.0f / CW); float s2 = 0.f;
#pragma unroll
            for (int j = 0; j < 4; ++j) { acc[i][j] = acc[i][j] - mean; s2 += acc[i][j].x * acc[i][j].x + acc[i][j].y * acc[i][j].y; }
            const float rstd = __builtin_amdgcn_rsqf(wave_sum(s2) * (1.0f / CW) + EPS);
            unsigned o[4];
#pragma unroll
            for (int j = 0; j < 4; ++j) { const f32x2 yv = acc[i][j] * rstd * g8[j] + b8[j]; o[j] = pk2(yv.x * fast_sigmoid(yv.x), yv.y * fast_sigmoid(yv.y)); }
            u32x4 w; w.x = o[0]; w.y = o[1]; w.z = o[2]; w.w = o[3];
            *(u32x4*)(OUT + (rowbase + t0 + t4 + i) * D + lane * 8) = w;
        }
    }
}

#ifndef MK_CG_ALL
#define MK_CG_ALL 0
#endif
#define PH_IN(k) (lo <= (k) && (k) < hi)
#define XB_TMO      128
#define XB_XCNT(j)  (256  + 64 * (j))
#define XB_XSUB(j)  (1280 + 64 * (j))
#define XB_XGEN(j)  (2304 + 64 * (j))
#define XB_TOP      3328
#define XB_TOPGEN   3392
#define XCD_BAR_WORDS 3456
#define XB_SPIN_CAP (1u << 18)
DI unsigned xb_ld(unsigned* p)              { return __hip_atomic_load(p, __ATOMIC_RELAXED, __HIP_MEMORY_SCOPE_AGENT); }
DI unsigned xb_add(unsigned* p, unsigned v) { return __hip_atomic_fetch_add(p, v, __ATOMIC_RELAXED, __HIP_MEMORY_SCOPE_AGENT); }
DI unsigned xb_xcc_id() { return (unsigned)__builtin_amdgcn_s_getreg((3 << 11) | 20) & 0xFu; }
#define XB_SPIN(cond, bar) do { unsigned _sp = 0; while (cond) { __builtin_amdgcn_s_sleep(1); \
    if ((++_sp & 255u) == 0u) { if (xb_ld(&(bar)[XB_TMO])) break; if (_sp > XB_SPIN_CAP) { atomicAdd(&(bar)[XB_TMO], 1u); break; } } } } while (0)
struct XcdBarrier { unsigned* bar; unsigned x; volatile LAS unsigned* st; };
DI XcdBarrier xcd_barrier_post(unsigned* bar, volatile LAS unsigned* st) {
    XcdBarrier b; b.bar = bar; b.x = xb_xcc_id(); b.st = st;
    if (threadIdx.x == 0) (void)xb_add(&bar[XB_XCNT(b.x)], 1u);
    return b;
}
DI void xcd_barrier_complete(unsigned* bar, unsigned x, unsigned& nloc, unsigned& nx) {
    const unsigned G = gridDim.x * gridDim.y * gridDim.z;
    unsigned sum, cnt, mine, sp = 0u;
    for (;;) {
        sum = 0u; cnt = 0u; mine = 0u;
#pragma unroll
        for (unsigned j = 0; j < 16; ++j) { const unsigned c = xb_ld(&bar[XB_XCNT(j)]); sum += c; cnt += (c > 0u) ? 1u : 0u; mine = (j == x) ? c : mine; }
        if (sum == G) break;
        __builtin_amdgcn_s_sleep(1);
        if ((++sp & 255u) == 0u) { if (xb_ld(&bar[XB_TMO])) break; if (sp > XB_SPIN_CAP) { atomicAdd(&bar[XB_TMO], 1u); break; } }
    }
    nloc = mine > 0u ? mine : 1u; nx = cnt > 0u ? cnt : 1u;
}
DI void xcd_barrier(const XcdBarrier& b) {
    asm volatile("s_waitcnt vmcnt(0)" ::: "memory");
    __syncthreads();
    if (threadIdx.x == 0) {
        unsigned* bar = b.bar;
        __builtin_amdgcn_s_waitcnt(0);
        unsigned nloc = b.st[0], nx = b.st[1];
        if (nloc == 0u) { xcd_barrier_complete(bar, b.x, nloc, nx); b.st[0] = nloc; b.st[1] = nx; }
        const unsigned old = xb_add(&bar[XB_XSUB(b.x)], 1u);
        const unsigned gen = old / nloc;
        if (old + 1u == (gen + 1u) * nloc) {
            __builtin_amdgcn_fence(__ATOMIC_RELEASE, "agent");
            asm volatile("s_waitcnt vmcnt(0)" ::: "memory");
            const unsigned og = xb_add(&bar[XB_TOP], 1u);
            const unsigned tg = og / nx;
            if (og + 1u == (tg + 1u) * nx) xb_add(&bar[XB_TOPGEN], 1u);
            else XB_SPIN(xb_ld(&bar[XB_TOPGEN]) == tg, bar);
            __builtin_amdgcn_fence(__ATOMIC_ACQUIRE, "agent");
            xb_add(&bar[XB_XGEN(b.x)], 1u);
            asm volatile("s_waitcnt vmcnt(0)" ::: "memory");
        } else {
            XB_SPIN(xb_ld(&bar[XB_XGEN(b.x)]) == gen, bar);
            __builtin_amdgcn_fence(__ATOMIC_ACQUIRE, "agent");
            asm volatile("s_waitcnt vmcnt(0)" ::: "memory");
        }
    }
    __syncthreads();
}
#ifndef MK_DUP
#define MK_DUP 0
#endif
#define PH_SEAM(k) do { if (PH_IN(k) && PH_IN((k) + 1)) { if (MK_CG_ALL || p.out == nullptr) grid.sync(); else xcd_barrier(bar);     } } while (0)
template <int L>
DI void layer_phases(const Params& p, LAS unsigned char* lds, const int lo, const int hi, cg::grid_group& grid, const XcdBarrier& bar) {
    unsigned char* ws = p.ws;
    float* mod = (float*)(ws + OFF_MOD); float* ssb = (float*)(ws + OFF_SS);
    bf16_t* H = (bf16_t*)(ws + OFF_H); bf16_t* MIX = (bf16_t*)(ws + OFF_MIX); bf16_t* XB = (bf16_t*)(ws + OFF_XB);
    bf16_t* Ub = (bf16_t*)(ws + OFF_U); bf16_t* QKV = (bf16_t*)(ws + OFF_QKV); bf16_t* RATIO = (bf16_t*)(ws + OFF_RATIO); bf16_t* SGA = (bf16_t*)(ws + OFF_SGA); bf16_t* HID = (bf16_t*)(ws + OFF_HID);
    const float* modl = mod + (size_t)L * NB * 6144;
    constexpr int P0 = 2 + 8 * L;
    if (PH_IN(P0)) { pg8::StaticOrder S; EpiIn E{Ub, QKV, RATIO, SGA, (float*)(ws + OFF_KN)}; S.init(M, INC, gridDim.x, blockIdx.x);
        for (int rep = 0; rep < ((L == 0 && (MK_DUP & 4)) ? 2 : 1); ++rep) pg8::gemm_phase(lds, pg8::Gemm{H, (const bf16_t*)(ws + OFF_WIN) + (size_t)L * INC * D, M, INC, D}, S, E); }
    PH_SEAM(P0);
    if (PH_IN(P0 + 1)) for (int rep = 0; rep < ((L == 0 && (MK_DUP & 2)) ? 2 : 1); ++rep) {
        __syncthreads();
        for (int it = blockIdx.x; it < 2048; it += gridDim.x) attn_block(QKV, (const float*)(ws + OFF_KN), MIX, lds, it >> 7, (it >> 5) & 3, it & 31);
        conv_load_w(p.conv_w + (size_t)L * CK * CW, lds);
        for (int it = blockIdx.x; it < 1024; it += gridDim.x)
            conv_item(Ub, MIX, p.conv_b + L * CW, p.conv_ln_g + L * CW, p.conv_ln_b + L * CW, lds, it);
    }
    PH_SEAM(P0 + 1);
    if (PH_IN(P0 + 2)) { pg8::StaticOrder S; EpiMix E{RATIO, SGA, H}; S.init(M, D, gridDim.x, blockIdx.x);
        for (int rep = 0; rep < ((L == 0 && (MK_DUP & 4)) ? 2 : 1); ++rep) pg8::gemm_phase(lds, pg8::Gemm{MIX, (const bf16_t*)(ws + OFF_WMIX) + (size_t)L * D * D, M, D, D}, S, E); }
    PH_SEAM(P0 + 2);
    if (PH_IN(P0 + 3)) { pg8::StaticOrder S; EpiY E{MIX, ssb + (size_t)(2 * L) * M * 16}; S.init(M, D, gridDim.x, blockIdx.x);
        for (int rep = 0; rep < ((L == 0 && (MK_DUP & 4)) ? 2 : 1); ++rep) pg8::gemm_phase(lds, pg8::Gemm{H, (const bf16_t*)(ws + OFF_WO) + (size_t)L * D * D, M, D, D}, S, E); }
    PH_SEAM(P0 + 3);
    if (PH_IN(P0 + 4)) rowpass(p.x, L == 0 ? nullptr : XB, MIX, ssb + (size_t)(2 * L) * M * 16, modl + 2048, p.post_mix_g + L * D, nullptr, XB, p.pre_ffn_g + L * D, modl + 4096, modl + 3072, H);
    PH_SEAM(P0 + 4);
    if (PH_IN(P0 + 5)) { pg8::StaticOrder S; EpiF1 E{HID}; S.init(M, 2 * DFF, gridDim.x, blockIdx.x);
        for (int rep = 0; rep < ((L == 0 && (MK_DUP & 4)) ? 2 : 1); ++rep) pg8::gemm_phase(lds, pg8::Gemm{H, (const bf16_t*)(ws + OFF_WF1) + (size_t)L * 2 * DFF * D, M, 2 * DFF, D}, S, E); }
    PH_SEAM(P0 + 5);
    if (PH_IN(P0 + 6)) { pg8::StaticOrder S; EpiY E{MIX, ssb + (size_t)(2 * L + 1) * M * 16}; S.init(M, D, gridDim.x, blockIdx.x);
        for (int rep = 0; rep < ((L == 0 && (MK_DUP & 4)) ? 2 : 1); ++rep) pg8::gemm_phase(lds, pg8::Gemm{HID, (const bf16_t*)(ws + OFF_WF2) + (size_t)L * D * DFF, M, D, DFF}, S, E); }
    PH_SEAM(P0 + 6);
    if (PH_IN(P0 + 7)) { constexpr bool lastl = (L == DEPTH - 1); const float* modn = modl + (size_t)NB * 6144;
        rowpass(nullptr, XB, MIX, ssb + (size_t)(2 * L + 1) * M * 16, modl + 5120, p.post_ffn_g + L * D, p.out, lastl ? nullptr : XB,
                lastl ? nullptr : p.pre_mix_g + (lastl ? 0 : L + 1) * D, modn + 1024, modn, H); }
    if (L + 1 < DEPTH) PH_SEAM(P0 + 7);
}

__global__ __launch_bounds__(512, 2) void fwd_megakernel(Params p) {
    extern __shared__ __attribute__((aligned(16))) unsigned char shm[];
    LAS unsigned char* lds = (LAS unsigned char*)shm;
    cg::grid_group grid = cg::this_grid();
    const int lo = p.ph_lo, hi = p.ph_hi;
    volatile LAS unsigned* st = (volatile LAS unsigned*)(lds + 135168);
    if (threadIdx.x < 4) st[threadIdx.x] = 0u;
    __syncthreads();
    XcdBarrier bar; bar.bar = (unsigned*)(p.ws + OFF_BAR); bar.x = 0; bar.st = st;
    if (hi - lo > 2) bar = xcd_barrier_post((unsigned*)(p.ws + OFF_BAR), st);
    if (PH_IN(0)) { phase0(p, lds); if (MK_DUP & 1) { __syncthreads(); phase0(p, lds); } }
    PH_SEAM(0);
    if (PH_IN(1)) { float* mod = (float*)(p.ws + OFF_MOD); for (int rep = 0; rep < ((MK_DUP & 1) ? 2 : 1); ++rep) rowpass(p.x, nullptr, nullptr, nullptr, nullptr, nullptr, nullptr, nullptr, p.pre_mix_g, mod + 1024, mod, (bf16_t*)(p.ws + OFF_H)); }
    PH_SEAM(1);
    layer_phases<0>(p, lds, lo, hi, grid, bar);
    layer_phases<1>(p, lds, lo, hi, grid, bar);
}


#ifndef MK_CHECK
#define MK_CHECK 0
#endif
#if MK_CHECK
DI float bfr(float x) { return bf_lo(pk2(x, 0.f)); }
DI float ldbf(const bf16_t* p) { return __uint_as_float(((unsigned)*p) << 16); }
DI unsigned hsh(unsigned x) { x ^= x >> 16; x *= 0x7feb352du; x ^= x >> 15; x *= 0x846ca68bu; x ^= x >> 16; return x; }
DI void diag_max(const Params& p, int stage, float got, float ref) {
    float e = fabsf(got - ref) / (fabsf(ref) + 0.05f); if (!(e == e)) e = 1e9f;
    atomicMax((unsigned*)(p.ws + OFF_DIAG) + stage, __float_as_uint(e));
}
DI float dotA(const bf16_t* a, const float* w, int ldw, int K) { float s = 0.f; for (int k = 0; k < K; ++k) s += ldbf(a + k) * bfr(w[(size_t)k * ldw]); return s; }
DI float sigm(float x) { return 1.0f / (1.0f + expf(-x)); }
__global__ void chk_kernel(Params p, int stage) {
    const unsigned id = blockIdx.x * blockDim.x + threadIdx.x; const unsigned h1 = hsh(id * 2654435761u + stage * 977u), h2 = hsh(h1 + 12345u);
    unsigned char* ws = p.ws; const float* mod = (const float*)(ws + OFF_MOD); const float* ssb = (const float*)(ws + OFF_SS);
    const bf16_t* H = (const bf16_t*)(ws + OFF_H); const bf16_t* MIX = (const bf16_t*)(ws + OFF_MIX); const bf16_t* Ub = (const bf16_t*)(ws + OFF_U); const bf16_t* QKV = (const bf16_t*)(ws + OFF_QKV);
    const bf16_t* RATIO = (const bf16_t*)(ws + OFF_RATIO); const bf16_t* SGA = (const bf16_t*)(ws + OFF_SGA); const bf16_t* HID = (const bf16_t*)(ws + OFF_HID);
    int row = h1 % M; if ((id & 7) == 0) row = (row & ~4095) + (h2 % 40); const int b = row >> 12;
    if (stage == 1) { const int l = id & 1, bb = (id >> 1) & 15, col = h1 % 6144; float s = p.ada_b[l * 6144 + col];
        for (int k = 0; k < D; ++k) { const float c = p.c[bb * D + k]; s += c * sigm(c) * p.ada_w[((size_t)l * D + k) * 6144 + col]; }
        diag_max(p, 1, mod[(l * NB + bb) * 6144 + col], s); }
    if (stage == 2) { float q = 0.f; for (int k = 0; k < D; ++k) { const float v = p.x[(size_t)row * D + k]; q += v * v; }
        const float rs = 1.0f / sqrtf(q / D + EPS); const int col = h2 % D;
        const float ref = p.x[(size_t)row * D + col] * rs * p.pre_mix_g[col] * (1.0f + mod[b * 6144 + 1024 + col]) + mod[b * 6144 + col];
        diag_max(p, 2, ldbf(H + (size_t)row * D + col), ref); }
    if (stage == 3) { const bf16_t* a = H + (size_t)row * D; const int t = id & 3;
        if (t == 0) { const int ch = h2 % CW; const float v = dotA(a, p.w_in + ch, INC, D), g = dotA(a, p.w_in + 512 + ch, INC, D); diag_max(p, 3, ldbf(Ub + (size_t)row * CW + ch), v * sigm(g)); }
        else if (t == 1) { const int c = h2 % 1536; const float v = dotA(a, p.w_in + 1024 + c, INC, D) * (c < 512 ? 0.125f * LOG2E : 1.0f); diag_max(p, 3, ldbf(QKV + (size_t)row * 1536 + c), v); }
        else { const int ch = h2 % D; const float gc = dotA(a, p.w_in + 2560 + ch, INC, D), ga = dotA(a, p.w_in + 3584 + ch, INC, D);
            if (t == 2) diag_max(p, 3, ldbf(RATIO + (size_t)row * D + ch), sigm(gc) / sigm(ga)); else diag_max(p, 3, ldbf(SGA + (size_t)row * D + ch), sigm(ga)); } }
    if (stage == 4) { const int s0 = row & 4095; float s1 = 0.f, s2 = 0.f; const int chs = h2 % CW; float vs = 0.f;
        for (int ch = 0; ch < CW; ++ch) { float a = p.conv_b[ch];
            for (int k = 0; k < CK; ++k) { const int s = s0 - 30 + k; if (s >= 0) a += bfr(p.conv_w[k * CW + ch]) * ldbf(Ub + ((size_t)(row - s0 + s)) * CW + ch); }
            s1 += a; s2 += a * a; if (ch == chs) vs = a; }
        const float mean = s1 / CW, var = s2 / CW - mean * mean; const float yv = (vs - mean) / sqrtf(var + EPS) * p.conv_ln_g[chs] + p.conv_ln_b[chs];
        diag_max(p, 4, ldbf(MIX + (size_t)row * D + chs), yv * sigm(yv)); }
    if (stage == 5) { const int hh = h2 & 7, d4 = ((h2 >> 3) & 15) * 4; int t = row & 4095; if ((id & 3) == 1) t &= 255; if ((id & 3) == 2) t &= 63; const size_t rb = (size_t)b * SEQ;
        const bf16_t* q = QKV + (rb + t) * 1536 + hh * 64; float o0 = 0.f, o1 = 0.f, o2 = 0.f, o3 = 0.f, run = 0.f;
        for (int s = t - 1; s >= 0; --s) { const bf16_t* kk = QKV + (rb + s) * 1536 + 512 + hh * 64; float z = 0.f; for (int d = 0; d < 64; ++d) z += ldbf(q + d) * ldbf(kk + d);
            run += fmaxf(z, 0.f) + log2f(1.0f + exp2f(-fabsf(z))); const float a = exp2f(z - run); const bf16_t* vv = kk + 512 + d4;
            o0 += a * ldbf(vv); o1 += a * ldbf(vv + 1); o2 += a * ldbf(vv + 2); o3 += a * ldbf(vv + 3); if (run > 200.f) break; }
        const bf16_t* o = MIX + (rb + t) * D + CW + hh * 64 + d4;
        diag_max(p, 5, ldbf(o), o0); diag_max(p, 5, ldbf(o + 1), o1); diag_max(p, 5, ldbf(o + 2), o2); diag_max(p, 5, ldbf(o + 3), o3); }
    if (stage == 6) { const int col = h2 % D; const bf16_t* a = MIX + (size_t)row * D; const float yc = dotA(a, p.w_conv_out + col, D, CW), ya = dotA(a + CW, p.w_att_out + col, D, CW);
        diag_max(p, 6, ldbf(H + (size_t)row * D + col), ldbf(SGA + (size_t)row * D + col) * (ldbf(RATIO + (size_t)row * D + col) * yc + ya)); }
    if (stage == 7 || stage == 10) { const int col = h2 % D; const bool f = (stage == 10);
        const float ref = f ? dotA(HID + (size_t)row * DFF, p.w_ffn_out + col, D, DFF) : dotA(H + (size_t)row * D, p.w_o + col, D, D);
        diag_max(p, stage, ldbf(MIX + (size_t)row * D + col), ref);
        if ((id & 15) == 0) { float q = 0.f; for (int k = 0; k < D; ++k) { const float v = ldbf(MIX + (size_t)row * D + k); q += v * v; } float sq = 0.f; for (int k = 0; k < 16; ++k) sq += ssb[((size_t)(f ? M : 0) + row) * 16 + k]; diag_max(p, stage, sq, q); } }
    if (stage == 8 || stage == 11) { const bool f = (stage == 11); const int col = h2 % D; const float* xin = f ? p.out : p.x;
        float sq = 0.f; for (int k = 0; k < 16; ++k) sq += ssb[((size_t)(f ? M : 0) + row) * 16 + k];
        const float rs = 1.0f / sqrtf(sq / D + EPS);
        if (!f) { const float ref = xin[(size_t)row * D + col] + mod[b * 6144 + 2048 + col] * ldbf(MIX + (size_t)row * D + col) * rs * p.post_mix_g[col]; diag_max(p, 8, p.out[(size_t)row * D + col], ref); }
        float q = 0.f; for (int k = 0; k < D; ++k) { const float v = p.out[(size_t)row * D + k]; q += v * v; }
        const float r2 = 1.0f / sqrtf(q / D + EPS);
        const float ref = f ? p.out[(size_t)row * D + col] * r2 * p.pre_mix_g[D + col] * (1.0f + mod[(NB + b) * 6144 + 1024 + col]) + mod[(NB + b) * 6144 + col]
                            : p.out[(size_t)row * D + col] * r2 * p.pre_ffn_g[col] * (1.0f + mod[b * 6144 + 4096 + col]) + mod[b * 6144 + 3072 + col];
        diag_max(p, stage, ldbf(H + (size_t)row * D + col), ref); }
    if (stage == 9) { const int ch = h2 % DFF; const bf16_t* a = H + (size_t)row * D; const float g = dotA(a, p.w_ffn_in + ch, 2 * DFF, D), u = dotA(a, p.w_ffn_in + DFF + ch, 2 * DFF, D);
        diag_max(p, 9, ldbf(HID + (size_t)row * DFF + ch), g * sigm(g) * u); }
}
__global__ void chk_report(Params p) {
    const unsigned* dg = (const unsigned*)(p.ws + OFF_DIAG); int first = 0, second = 0;
    for (int s = 1; s <= 11; ++s) if (__uint_as_float(dg[s]) > 0.04f) { if (!first) first = s; else if (!second) second = s; }
    if (first) p.out[0] = 1000.0f * (10 * (first % 10) + (second % 10)) + (first >= 10 ? 500.f : 0.f);
}
#endif

#ifndef MK_PER_PHASE
#define MK_PER_PHASE 0
#endif
extern "C" void kernel_launch(void* const* d_in, const int* in_sizes, int n_in, void* d_out, int out_size, void* d_ws, size_t ws_size, hipStream_t stream) {
    static int grid = 0;
    if (grid == 0) {
        if (n_in != 18 || in_sizes[0] != M * D || out_size != M * D || ws_size < WS_END) { fprintf(stderr, "kernel_launch: unexpected shapes (n_in %d in0 %d out %d ws %zu need %zu)\n", n_in, in_sizes[0], out_size, ws_size, (size_t)WS_END); grid = -1; return; }
        int dev = 0, cus = 0, per_cu = 0;
        hipGetDevice(&dev); hipDeviceGetAttribute(&cus, hipDeviceAttributeMultiprocessorCount, dev);
        if (hipFuncSetAttribute((const void*)fwd_megakernel, hipFuncAttributeMaxDynamicSharedMemorySize, LDS_BYTES) != hipSuccess) { fprintf(stderr, "kernel_launch: hipFuncSetAttribute failed\n"); grid = -1; return; }
        if (hipOccupancyMaxActiveBlocksPerMultiprocessor(&per_cu, (const void*)fwd_megakernel, 512, LDS_BYTES) != hipSuccess || per_cu < 1) { fprintf(stderr, "kernel_launch: occupancy query failed (%d)\n", per_cu); (void)hipGetLastError(); per_cu = 1; }
        grid = cus * per_cu;
    }
    if (grid < 0) return;
    (void)hipMemsetAsync((unsigned char*)d_ws + OFF_DIAG, 0, ZERO_BYTES, stream);
    Params p{};
    const float** pp = (const float**)&p;
    for (int i = 0; i < 18; ++i) pp[i] = (const float*)d_in[i];
    p.out = (float*)d_out; p.ws = (unsigned char*)d_ws;
#if MK_PER_PHASE
    for (int ph = 0; ph < NPHASE; ++ph) { p.ph_lo = ph; p.ph_hi = ph + 1;
        hipLaunchKernelGGL(fwd_megakernel, dim3(grid), dim3(512), LDS_BYTES, stream, p);
#if MK_CHECK
        { Params q = p; q.ph_lo = 0; q.ph_hi = 0;
          auto CH = [&](int st) { hipLaunchKernelGGL(chk_kernel, dim3(8), dim3(64), 0, stream, q, st); };
          if (ph == 1) { CH(1); CH(2); } if (ph == 2) CH(3); if (ph == 3) { CH(4); CH(5); } if (ph == 4) CH(6); if (ph == 5) CH(7); if (ph == 6) CH(8);
          if (ph == 7) CH(9); if (ph == 8) CH(10); if (ph == 9) CH(11);
          if (ph == NPHASE - 1) hipLaunchKernelGGL(chk_report, dim3(1), dim3(1), 0, stream, q); }
#endif
    }
#else
    p.ph_lo = 0; p.ph_hi = NPHASE;
    void* args[] = {&p};
    hipError_t e = hipLaunchCooperativeKernel((const void*)fwd_megakernel, dim3(grid), dim3(512), args, LDS_BYTES, stream);
    if (e != hipSuccess) fprintf(stderr, "cooperative launch failed: %s (grid %d)\n", hipGetErrorString(e), grid);
#endif
}
```

```cpp
#include <hip/hip_runtime.h>
#include <hip/hip_cooperative_groups.h>
#include <cstdio>
#include <cstdint>
namespace cg = cooperative_groups;

#define DI __device__ __forceinline__
#define LAS __attribute__((address_space(3)))
typedef unsigned short bf16_t;
typedef short bf16x8 __attribute__((ext_vector_type(8)));
typedef short s16x4 __attribute__((ext_vector_type(4)));
typedef float f32x2 __attribute__((ext_vector_type(2)));
typedef float f32x4 __attribute__((ext_vector_type(4)));
typedef float f32x16 __attribute__((ext_vector_type(16)));
typedef unsigned u32x2 __attribute__((ext_vector_type(2)));
typedef unsigned u32x4 __attribute__((ext_vector_type(4)));
typedef __bf16 bf2_t __attribute__((ext_vector_type(2)));

constexpr int D = 1024, NB = 16, SEQ = 4096, M = NB * SEQ, DEPTH = 2;
constexpr int CW = 512, CK = 31, NH = 8, HD = 64, DFF = 2816, INC = 4608;
constexpr float EPS = 1e-6f;
constexpr float LOG2E = 1.4426950408889634f;
constexpr int LDS_BYTES = 135168 + 64;
constexpr int NPHASE = 2 + 8 * DEPTH;

constexpr size_t OFF_MOD = 0;
constexpr size_t OFF_DIAG = 786432;
constexpr size_t OFF_BAR = OFF_DIAG + 256;
constexpr size_t ZERO_BYTES = 256 + 3456 * 4;
constexpr size_t OFF_KN = 802816;
constexpr size_t OFF_WIN = 2097152;
constexpr size_t OFF_WMIX = OFF_WIN + 2ull * INC * D * 2;
constexpr size_t OFF_WO = OFF_WMIX + 2ull * D * D * 2;
constexpr size_t OFF_WF1 = OFF_WO + 2ull * D * D * 2;
constexpr size_t OFF_WF2 = OFF_WF1 + 2ull * 2 * DFF * D * 2;
constexpr size_t OFF_H = 67108864;
constexpr size_t OFF_MIX = OFF_H + (size_t)M * D * 2;
constexpr size_t OFF_R = OFF_MIX + (size_t)M * D * 2;
constexpr size_t OFF_U = OFF_R;
constexpr size_t OFF_QKV = OFF_U + (size_t)M * CW * 2;
constexpr size_t OFF_RATIO = OFF_QKV + (size_t)M * 1536 * 2;
constexpr size_t OFF_SGA = OFF_RATIO + (size_t)M * D * 2;
constexpr size_t OFF_HID = OFF_R;
constexpr size_t WS_END_ACT = OFF_SGA + (size_t)M * D * 2;
constexpr size_t OFF_SS = WS_END_ACT;
constexpr size_t OFF_XB = WS_END_ACT + 4ull * M * 16 * 4;
constexpr size_t WS_END = OFF_XB + (size_t)M * D * 2;
static_assert(OFF_WF2 + 2ull * D * DFF * 2 <= OFF_H, "weights overflow");
static_assert(OFF_HID + (size_t)M * DFF * 2 <= WS_END, "hid overflow");

struct Params {
    const float *x, *c, *ada_w, *ada_b, *pre_mix_g, *post_mix_g, *pre_ffn_g, *post_ffn_g, *w_in, *conv_w, *conv_b, *conv_ln_g, *conv_ln_b,
        *w_conv_out, *w_att_out, *w_o, *w_ffn_in, *w_ffn_out;
    float* out; unsigned char* ws; int ph_lo, ph_hi;
};

DI unsigned pk2(float a, float b) { f32x2 v = {a, b}; bf2_t r = __builtin_convertvector(v, bf2_t); return __builtin_bit_cast(unsigned, r); }
DI float bf_lo(unsigned w) { return __uint_as_float(w << 16); }
DI float bf_hi(unsigned w) { return __uint_as_float(w & 0xffff0000u); }
DI float fast_sigmoid(float x) { return __builtin_amdgcn_rcpf(1.0f + __builtin_amdgcn_exp2f(-x * LOG2E)); }
DI float wave_sum(float v) {
#pragma unroll
    for (int o = 1; o < 64; o <<= 1) v += __shfl_xor(v, o);
    return v;
}

namespace pg8 {
constexpr int BM = 256, BK = 64, HALF = 128, HTB = HALF * BK * 2, STAGE_BYTES = 8 * HTB, NXCD = 8, WGM = 4;
DI int lds_byte(int r, int c) { const int st = (r >> 4) * 2 + (c >> 5), rr = r & 15, cc = c & 31, ob = rr * 64 + cc * 2; return st * 1024 + (ob ^ (((ob >> 9) & 1) << 5)); }
DI void stage_rc(int b, int& R, int& C) { const int st = b / 1024, sb = b % 1024, swz = sb ^ (((sb >> 9) & 1) << 5); R = (st >> 1) * 16 + swz / 64; C = (st & 1) * 32 + (swz % 64) / 2; }
DI int perm32(int rho) { const int n = rho >> 4, i = rho & 15; return 8 * (i >> 2) + 4 * n + (i & 3); }
struct Unit { int pm, pn; };
struct Gemm { const bf16_t* A; const bf16_t* Bt; int M, N, K; };
struct StaticOrder {
    int nM, nN, nwg, G, c;
    DI void init(int M_, int N_, int G_, int c_) { nM = M_ / BM; nN = N_ / BM; nwg = nM * nN; G = G_; c = c_; }
    DI bool next(int i, Unit& u) const {
        const long L = (long)i * G + c; if (L >= nwg) return false;
        int wgid = (int)L; { const int q = nwg / NXCD, r = nwg % NXCD, xcd = wgid % NXCD, off = wgid / NXCD; wgid = (xcd < r ? xcd * (q + 1) : r * (q + 1) + (xcd - r) * q) + off; }
        const int nig = WGM * nN, gid = wgid / nig, fm = gid * WGM, gsz = (nM - fm) < WGM ? (nM - fm) : WGM;
        u.pm = fm + ((wgid % nig) % gsz); u.pn = (wgid % nig) / gsz; return true;
    }
};
#ifndef MK_ALIGN
#define MK_ALIGN false
#endif
#ifndef MK_SP2
#define MK_SP2 true
#endif
template <class Epi, bool ALIGN_EPI = MK_ALIGN, bool SP2 = MK_SP2>
DI void gemm_phase(LAS unsigned char* lds, const Gemm g, const StaticOrder& S, const Epi& E) {
    const int tid = threadIdx.x, wid = __builtin_amdgcn_readfirstlane(tid >> 6), lane = tid & 63, wr = wid >> 2, wc = wid & 3, fr = lane & 15, fq = lane >> 4;
    const int K = g.K, nt = K / BK;
    unsigned voffA[2];
#pragma unroll
    for (int i = 0; i < 2; ++i) { int R, C; stage_rc(tid * 16 + i * 8192, R, C); voffA[i] = (unsigned)(R * K + C) * 2u; }
    const size_t kstep = (size_t)(BK * 2);
    const size_t hstep = (size_t)HALF * K * 2;
    const size_t tstep = 2 * hstep;
    const unsigned ldsw = (unsigned)wid * 1024u;
    const int aoff = lds_byte(wr * 64 + fr, fq * 8), boff = lds_byte(wc * 32 + fr, fq * 8);
#define PG8_SA(b, h) (((b) * 2 + (h)) * HTB)
#define PG8_SB(b, h) ((4 + (b) * 2 + (h)) * HTB)
#define PG8_STAGE(bufoff, gbase) do { _Pragma("unroll") for (int _i = 0; _i < 2; ++_i) \
        __builtin_amdgcn_global_load_lds((const unsigned*)((const char*)(gbase) + voffA[_i]), (LAS unsigned*)(lds + (bufoff) + ldsw + _i * 8192), 16, 0, 0); } while (0)
#define PG8_LDA(dst, b, h) do { _Pragma("unroll") for (int m = 0; m < 4; ++m) _Pragma("unroll") for (int k = 0; k < 2; ++k) dst[m][k] = *(const LAS bf16x8*)(lds + PG8_SA(b, h) + aoff + m * 2048 + k * 1024); } while (0)
#define PG8_LDB(dst, b, h) do { _Pragma("unroll") for (int n = 0; n < 2; ++n) _Pragma("unroll") for (int k = 0; k < 2; ++k) dst[n][k] = *(const LAS bf16x8*)(lds + PG8_SB(b, h) + boff + n * 2048 + k * 1024); } while (0)
#define PG8_MMA(ai, bj, At, Bt) do { __builtin_amdgcn_s_setprio(1); _Pragma("unroll") for (int m = 0; m < 4; ++m) _Pragma("unroll") for (int n = 0; n < 2; ++n) _Pragma("unroll") for (int k = 0; k < 2; ++k) \
        acc[ai][bj][m][n] = __builtin_amdgcn_mfma_f32_16x16x32_bf16(Bt[n][k], At[m][k], acc[ai][bj][m][n], 0, 0, 0); __builtin_amdgcn_s_setprio(0); } while (0)
#define PG8_WAIT_V(n) asm volatile("s_waitcnt vmcnt(" #n ")" ::: "memory")
#define PG8_WAIT_L(n) asm volatile("s_waitcnt lgkmcnt(" #n ")" ::: "memory")
#define PG8_BAR __builtin_amdgcn_s_barrier()
#define PG8_SCHED __builtin_amdgcn_sched_barrier(0)
    Unit cur, nxt; int ui = 0;
    if (!S.next(0, cur)) return;
    f32x4 acc[2][2][4][2];
#pragma unroll
    for (int a = 0; a < 2; ++a)
#pragma unroll
        for (int b = 0; b < 2; ++b)
#pragma unroll
            for (int m = 0; m < 4; ++m)
#pragma unroll
                for (int n = 0; n < 2; ++n) acc[a][b][m][n] = (f32x4){0.f, 0.f, 0.f, 0.f};
    bf16x8 At[4][2], B0[2][2], B1[2][2];
    const char* cA = (const char*)g.A + (size_t)cur.pm * tstep; const char* cB = (const char*)g.Bt + (size_t)cur.pn * tstep;
    if constexpr (SP2) {
        PG8_STAGE(PG8_SB(0, 0), cB); PG8_STAGE(PG8_SB(0, 1), cB + hstep); PG8_STAGE(PG8_SA(0, 0), cA); PG8_STAGE(PG8_SA(0, 1), cA + hstep);
        if (wr == 1) PG8_BAR;
        PG8_WAIT_V(2); PG8_BAR;
        PG8_STAGE(PG8_SB(1, 0), cB + kstep); PG8_STAGE(PG8_SA(1, 0), cA + kstep); PG8_STAGE(PG8_SB(1, 1), cB + hstep + kstep);
        PG8_WAIT_V(6); PG8_BAR;
    } else {
        PG8_STAGE(PG8_SB(0, 0), cB); PG8_STAGE(PG8_SA(0, 0), cA); PG8_STAGE(PG8_SB(0, 1), cB + hstep); PG8_STAGE(PG8_SA(0, 1), cA + hstep);
        if (wr == 1) PG8_BAR;
        PG8_WAIT_V(4); PG8_BAR;
        PG8_STAGE(PG8_SB(1, 0), cB + kstep); PG8_STAGE(PG8_SA(1, 0), cA + kstep); PG8_STAGE(PG8_SB(1, 1), cB + hstep + kstep);
        PG8_WAIT_V(6); PG8_BAR;
    }
    for (;;) {
        const bool has_next = S.next(ui + 1, nxt);
        const char* nA = has_next ? (const char*)g.A + (size_t)nxt.pm * tstep : cA; const char* nB = has_next ? (const char*)g.Bt + (size_t)nxt.pn * tstep : cB;
        for (int t = 0; t < nt; t += 2) {
            if constexpr (Epi::MIDK) { if (t == (nt >> 1)) E.mid(acc, cur, wr, wc, fr, fq); }
            const bool last = (t == nt - 2);
            const char* a1 = cA + (size_t)(t + 1) * kstep;
            const char* a2 = last ? nA : cA + (size_t)(t + 2) * kstep; const char* b2 = last ? nB : cB + (size_t)(t + 2) * kstep;
            const char* a3 = a2 + kstep; const char* b3 = b2 + kstep;
            if constexpr (SP2) {
            PG8_LDB(B0, 0, 0); PG8_LDB(B1, 0, 1); PG8_SCHED; PG8_LDA(At, 0, 0); PG8_STAGE(PG8_SA(1, 1), a1 + hstep);
            PG8_WAIT_V(8); PG8_WAIT_L(0); PG8_BAR; PG8_MMA(0, 0, At, B0); PG8_MMA(0, 1, At, B1); PG8_BAR; PG8_SCHED;
            PG8_LDA(At, 0, 1); PG8_STAGE(PG8_SB(0, 0), b2); PG8_STAGE(PG8_SB(0, 1), b2 + hstep); PG8_STAGE(PG8_SA(0, 0), a2);
            PG8_WAIT_V(8); PG8_WAIT_L(0); PG8_BAR; PG8_MMA(1, 0, At, B0); PG8_MMA(1, 1, At, B1); PG8_BAR; PG8_SCHED;
            PG8_LDB(B0, 1, 0); PG8_LDB(B1, 1, 1); PG8_SCHED; PG8_LDA(At, 1, 0); PG8_STAGE(PG8_SA(0, 1), a2 + hstep);
            PG8_WAIT_V(8); PG8_WAIT_L(0); PG8_BAR; PG8_MMA(0, 0, At, B0); PG8_MMA(0, 1, At, B1); PG8_BAR; PG8_SCHED;
            PG8_LDA(At, 1, 1); PG8_STAGE(PG8_SB(1, 0), b3); PG8_STAGE(PG8_SB(1, 1), b3 + hstep); PG8_STAGE(PG8_SA(1, 0), a3);
            PG8_WAIT_V(8); PG8_WAIT_L(0); PG8_BAR; PG8_MMA(1, 0, At, B0); PG8_MMA(1, 1, At, B1); PG8_BAR; PG8_SCHED;
            } else {
            PG8_LDB(B0, 0, 0); PG8_SCHED; PG8_LDA(At, 0, 0); PG8_STAGE(PG8_SA(1, 1), a1 + hstep);
            PG8_WAIT_L(8); PG8_BAR; PG8_WAIT_L(0); PG8_MMA(0, 0, At, B0); PG8_BAR; PG8_SCHED;
            PG8_LDB(B1, 0, 1); PG8_STAGE(PG8_SB(0, 0), b2);
            PG8_BAR; PG8_WAIT_L(0); PG8_MMA(0, 1, At, B1); PG8_BAR;
            PG8_LDA(At, 0, 1); PG8_STAGE(PG8_SA(0, 0), a2);
            PG8_BAR; PG8_WAIT_L(0); PG8_MMA(1, 0, At, B0); PG8_BAR; PG8_SCHED;
            PG8_STAGE(PG8_SB(0, 1), b2 + hstep);
            PG8_WAIT_V(6); PG8_BAR; PG8_MMA(1, 1, At, B1); PG8_BAR;
            PG8_LDB(B0, 1, 0); PG8_SCHED; PG8_LDA(At, 1, 0); PG8_STAGE(PG8_SA(0, 1), a2 + hstep);
            PG8_WAIT_L(8); PG8_BAR; PG8_WAIT_L(0); PG8_MMA(0, 0, At, B0); PG8_BAR; PG8_SCHED;
            PG8_LDB(B1, 1, 1); PG8_STAGE(PG8_SB(1, 0), b3);
            PG8_BAR; PG8_WAIT_L(0); PG8_MMA(0, 1, At, B1); PG8_BAR;
            PG8_LDA(At, 1, 1); PG8_STAGE(PG8_SA(1, 0), a3);
            PG8_BAR; PG8_WAIT_L(0); PG8_MMA(1, 0, At, B0); PG8_BAR; PG8_SCHED;
            PG8_STAGE(PG8_SB(1, 1), b3 + hstep);
            PG8_WAIT_V(6); PG8_BAR; PG8_MMA(1, 1, At, B1); PG8_BAR;
            }
        }
        if constexpr (ALIGN_EPI) { if (wr == 0) PG8_BAR; }
        E(acc, cur, wr, wc, fr, fq);
        if (!has_next) break;
#pragma unroll
        for (int a = 0; a < 2; ++a)
#pragma unroll
            for (int b = 0; b < 2; ++b)
#pragma unroll
                for (int m = 0; m < 4; ++m)
#pragma unroll
                    for (int n = 0; n < 2; ++n) acc[a][b][m][n] = (f32x4){0.f, 0.f, 0.f, 0.f};
        cur = nxt; cA = nA; cB = nB; ++ui;
        if constexpr (ALIGN_EPI) { if (wr == 1) PG8_BAR; }
    }
    PG8_WAIT_V(0);
    if constexpr (!ALIGN_EPI) { if (wr == 0) PG8_BAR; }
    PG8_BAR;
#undef PG8_SA
#undef PG8_SB
#undef PG8_STAGE
#undef PG8_LDA
#undef PG8_LDB
#undef PG8_MMA
#undef PG8_WAIT_V
#undef PG8_WAIT_L
#undef PG8_BAR
#undef PG8_SCHED
}
}
using pg8::Unit;
typedef f32x4 AccT[2][2][4][2];

struct EpiIn {
    static constexpr bool MIDK = false;
    bf16_t *U, *QKV, *RATIO, *SGA; float* KN;
    DI void mid(AccT&, const Unit&, int, int, int, int) const {}
    DI void operator()(const AccT& acc, const Unit& u, int wr, int wc, int fr, int fq) const {
        const int row0 = u.pm * 256 + wr * 64 + fr;
        if (u.pn < 4) {
#pragma unroll
            for (int ai = 0; ai < 2; ++ai)
#pragma unroll
                for (int m = 0; m < 4; ++m) { const size_t row = (size_t)(row0 + ai * 128 + m * 16); const int ch0 = u.pn * 128 + wc * 32 + fq * 8; float o[8];
#pragma unroll
                    for (int n = 0; n < 2; ++n) { const f32x4 a = acc[ai][0][m][n], gt = acc[ai][1][m][n];
#pragma unroll
                        for (int j = 0; j < 4; ++j) o[4 * n + j] = a[j] * fast_sigmoid(gt[j]); }
                    u32x4 w; w.x = pk2(o[0], o[1]); w.y = pk2(o[2], o[3]); w.z = pk2(o[4], o[5]); w.w = pk2(o[6], o[7]);
                    *(u32x4*)(U + row * CW + ch0) = w; }
        } else if (u.pn < 10) {
            const float sc = (u.pn < 6) ? (0.125f * LOG2E) : 1.0f;
#pragma unroll
            for (int ai = 0; ai < 2; ++ai)
#pragma unroll
                for (int m = 0; m < 4; ++m) { const size_t row = (size_t)(row0 + ai * 128 + m * 16);
#pragma unroll
                    for (int bj = 0; bj < 2; ++bj) { const int col0 = (u.pn - 4) * 256 + bj * 128 + wc * 32 + fq * 8;
                        const f32x4 v0 = acc[ai][bj][m][0] * sc, v1 = acc[ai][bj][m][1] * sc;
                        u32x4 w; w.x = pk2(v0[0], v0[1]); w.y = pk2(v0[2], v0[3]); w.z = pk2(v1[0], v1[1]); w.w = pk2(v1[2], v1[3]);
                        *(u32x4*)(QKV + row * 1536 + col0) = w; } }
            if (u.pn == 6 || u.pn == 7) {
#pragma unroll
                for (int ai = 0; ai < 2; ++ai)
#pragma unroll
                    for (int bj = 0; bj < 2; ++bj) { float mx = 0.f;
#pragma unroll
                        for (int m = 0; m < 4; ++m) { const f32x4 v0 = acc[ai][bj][m][0], v1 = acc[ai][bj][m][1]; float q = 0.f;
#pragma unroll
                            for (int j = 0; j < 4; ++j) { const float a = bf_lo(pk2(v0[j], 0.f)), c = bf_lo(pk2(v1[j], 0.f)); q += a * a + c * c; }
                            q += __shfl_xor(q, 16); q += __shfl_xor(q, 32); mx = fmaxf(mx, q); }
#pragma unroll
                        for (int o = 1; o < 16; o <<= 1) mx = fmaxf(mx, __shfl_xor(mx, o));
                        const int rowb = u.pm * 256 + ai * 128 + wr * 64, hh = (u.pn - 6) * 4 + bj * 2 + (wc >> 1);
                        if ((fr | fq) == 0) KN[((size_t)(((rowb >> 12) * 8 + hh) * 64 + ((rowb & 4095) >> 6))) * 2 + (wc & 1)] = mx; }
            }
        } else {
#pragma unroll
            for (int ai = 0; ai < 2; ++ai)
#pragma unroll
                for (int m = 0; m < 4; ++m) { const size_t row = (size_t)(row0 + ai * 128 + m * 16); const int ch0 = (u.pn - 10) * 128 + wc * 32 + fq * 8; float r[8], s[8];
#pragma unroll
                    for (int n = 0; n < 2; ++n) { const f32x4 gc = acc[ai][0][m][n], ga = acc[ai][1][m][n];
#pragma unroll
                        for (int j = 0; j < 4; ++j) { const float ea = 1.0f + __builtin_amdgcn_exp2f(-fmaxf(ga[j], -80.f) * LOG2E);
                            s[4 * n + j] = __builtin_amdgcn_rcpf(ea); r[4 * n + j] = fast_sigmoid(gc[j]) * ea; } }
                    u32x4 wr_, ws_; wr_.x = pk2(r[0], r[1]); wr_.y = pk2(r[2], r[3]); wr_.z = pk2(r[4], r[5]); wr_.w = pk2(r[6], r[7]);
                    ws_.x = pk2(s[0], s[1]); ws_.y = pk2(s[2], s[3]); ws_.z = pk2(s[4], s[5]); ws_.w = pk2(s[6], s[7]);
                    *(u32x4*)(RATIO + row * D + ch0) = wr_; *(u32x4*)(SGA + row * D + ch0) = ws_; }
        }
    }
};
struct EpiMix {
    static constexpr bool MIDK = true;
    const bf16_t *RATIO, *SGA; bf16_t* O;
    DI void scale(AccT& acc, const bf16_t* T, const Unit& u, int wr, int wc, int fr, int fq) const {
        int row0 = u.pm * 256 + wr * 64 + fr; asm volatile("" : "+v"(row0));
        const bf16_t* Tp = T + (size_t)row0 * D + u.pn * 256 + wc * 32 + fq * 8;
#pragma unroll
        for (int ai = 0; ai < 2; ++ai)
#pragma unroll
            for (int m = 0; m < 4; ++m) {
#pragma unroll
                for (int bj = 0; bj < 2; ++bj) {
                    const u32x4 w = *(const u32x4*)(Tp + (ai * 128 + m * 16) * D + bj * 128);
                    acc[ai][bj][m][0] *= (f32x4){bf_lo(w.x), bf_hi(w.x), bf_lo(w.y), bf_hi(w.y)};
                    acc[ai][bj][m][1] *= (f32x4){bf_lo(w.z), bf_hi(w.z), bf_lo(w.w), bf_hi(w.w)}; } }
    }
    DI void mid(AccT& acc, const Unit& u, int wr, int wc, int fr, int fq) const { scale(acc, RATIO, u, wr, wc, fr, fq); }
    DI void operator()(AccT& acc, const Unit& u, int wr, int wc, int fr, int fq) const {
        scale(acc, SGA, u, wr, wc, fr, fq);
        const int row0 = u.pm * 256 + wr * 64 + fr;
#pragma unroll
        for (int ai = 0; ai < 2; ++ai)
#pragma unroll
            for (int m = 0; m < 4; ++m) { const size_t row = (size_t)(row0 + ai * 128 + m * 16);
#pragma unroll
                for (int bj = 0; bj < 2; ++bj) { const int col0 = u.pn * 256 + bj * 128 + wc * 32 + fq * 8;
                    const f32x4 v0 = acc[ai][bj][m][0], v1 = acc[ai][bj][m][1];
                    u32x4 w; w.x = pk2(v0[0], v0[1]); w.y = pk2(v0[2], v0[3]); w.z = pk2(v1[0], v1[1]); w.w = pk2(v1[2], v1[3]);
                    *(u32x4*)(O + row * D + col0) = w; } }
    }
};
struct EpiY {
    static constexpr bool MIDK = false;
    bf16_t* Y; float* ss;
    DI void mid(AccT&, const Unit&, int, int, int, int) const {}
    DI void operator()(const AccT& acc, const Unit& u, int wr, int wc, int fr, int fq) const {
        const int row0 = u.pm * 256 + wr * 64 + fr;
#pragma unroll
        for (int ai = 0; ai < 2; ++ai)
#pragma unroll
            for (int m = 0; m < 4; ++m) { const size_t row = (size_t)(row0 + ai * 128 + m * 16); float q = 0.f;
#pragma unroll
                for (int bj = 0; bj < 2; ++bj) { const int col0 = u.pn * 256 + bj * 128 + wc * 32 + fq * 8;
                    const f32x4 v0 = acc[ai][bj][m][0], v1 = acc[ai][bj][m][1];
                    q += (v0[0] * v0[0] + v0[1] * v0[1]) + (v0[2] * v0[2] + v0[3] * v0[3]) + (v1[0] * v1[0] + v1[1] * v1[1]) + (v1[2] * v1[2] + v1[3] * v1[3]);
                    u32x4 w; w.x = pk2(v0[0], v0[1]); w.y = pk2(v0[2], v0[3]); w.z = pk2(v1[0], v1[1]); w.w = pk2(v1[2], v1[3]);
                    *(u32x4*)(Y + row * D + col0) = w; }
                q += __shfl_xor(q, 16); q += __shfl_xor(q, 32);
                if (fq == 0) ss[row * 16 + u.pn * 4 + wc] = q; }
    }
};
struct EpiF1 {
    static constexpr bool MIDK = false;
    bf16_t* HID;
    DI void mid(AccT&, const Unit&, int, int, int, int) const {}
    DI void operator()(const AccT& acc, const Unit& u, int wr, int wc, int fr, int fq) const {
        const int row0 = u.pm * 256 + wr * 64 + fr;
#pragma unroll
        for (int ai = 0; ai < 2; ++ai)
#pragma unroll
            for (int m = 0; m < 4; ++m) { const size_t row = (size_t)(row0 + ai * 128 + m * 16); const int ch0 = u.pn * 128 + wc * 32 + fq * 8; float o[8];
#pragma unroll
                for (int n = 0; n < 2; ++n) { const f32x4 gt = acc[ai][0][m][n], up = acc[ai][1][m][n];
#pragma unroll
                    for (int j = 0; j < 4; ++j) o[4 * n + j] = gt[j] * fast_sigmoid(gt[j]) * up[j]; }
                u32x4 w; w.x = pk2(o[0], o[1]); w.y = pk2(o[2], o[3]); w.z = pk2(o[4], o[5]); w.w = pk2(o[6], o[7]);
                *(u32x4*)(HID + row * DFF + ch0) = w; }
    }
};

DI int src_pair(int np, int second_off) { const int pn = np >> 8, tc = np & 255, bj = tc >> 7, wc = (tc >> 5) & 3; return pn * 128 + wc * 32 + pg8::perm32(tc & 31) + bj * second_off; }
DI int src_nat(int np) { return (np & ~31) + pg8::perm32(np & 31); }
DI void tr_item(const float* W, int ldw, bf16_t* WT, int Kd, int kdst0, int ksrc0, int n0, int srccol, LAS float* scr, int lane) {
    const float* src = W + (size_t)ksrc0 * ldw + srccol;
#pragma unroll 8
    for (int i = 0; i < 32; ++i) { const int kk = 2 * i + (lane >> 5); scr[kk * 33 + (lane & 31)] = src[(size_t)kk * ldw]; }
    asm volatile("s_waitcnt lgkmcnt(0)" ::: "memory");
    const int c = lane & 7;
#pragma unroll
    for (int j = 0; j < 4; ++j) { const int n = (lane >> 3) + 8 * j; const LAS float* s = scr + (8 * c) * 33 + n;
        u32x4 o; o.x = pk2(s[0 * 33], s[1 * 33]); o.y = pk2(s[2 * 33], s[3 * 33]); o.z = pk2(s[4 * 33], s[5 * 33]); o.w = pk2(s[6 * 33], s[7 * 33]);
        *(u32x4*)(WT + (size_t)(n0 + n) * Kd + kdst0 + 8 * c) = o; }
    asm volatile("s_waitcnt lgkmcnt(0)" ::: "memory");
}
constexpr int TR_IN = 16 * 144, TR_MIX = 16 * 32, TR_O = 16 * 32, TR_F1 = 16 * 176, TR_F2 = 44 * 32, TR_LAYER = TR_IN + TR_MIX + TR_O + TR_F1 + TR_F2;
constexpr int MOD_ITEMS = 2 * 96 * 4;
DI void phase0(const Params& p, LAS unsigned char* lds) {
    const int lane = threadIdx.x & 63, wave = threadIdx.x >> 6;
    LAS float* scr = (LAS float*)(lds + wave * 16384);
    const int gw = blockIdx.x * 8 + wave, NGW = gridDim.x * 8;
    for (int q = blockIdx.x; q < 192; q += gridDim.x) {
        const int kc = wave, l = q / 96, col = (q % 96) * 64 + lane;
        const float* W = p.ada_w + (size_t)l * D * 6144 + col;
        float acc[16];
#pragma unroll
        for (int b = 0; b < 16; ++b) acc[b] = 0.f;
        for (int k0 = kc * 128; k0 < kc * 128 + 128; k0 += 16) {
            float w[16], sv[4];
#pragma unroll
            for (int kq = 0; kq < 16; ++kq) w[kq] = W[(size_t)(k0 + kq) * 6144];
#pragma unroll
            for (int g = 0; g < 4; ++g) { const float cv = p.c[(lane & 15) * D + k0 + 4 * g + (lane >> 4)]; sv[g] = cv * fast_sigmoid(cv); }
#pragma unroll
            for (int kq = 0; kq < 16; ++kq)
#pragma unroll
                for (int b = 0; b < 16; ++b) acc[b] += __uint_as_float(__builtin_amdgcn_readlane(__float_as_uint(sv[kq >> 2]), b + 16 * (kq & 3))) * w[kq];
        }
        LAS float* part = (LAS float*)lds;
#pragma unroll
        for (int b = 0; b < 16; ++b) part[(wave * 16 + b) * 64 + lane] = acc[b];
        __syncthreads();
        if (wave < 2) { float* mo = (float*)(p.ws + OFF_MOD) + (size_t)l * NB * 6144 + col; const float bias = p.ada_b[l * 6144 + col];
#pragma unroll
            for (int bb = 0; bb < 8; ++bb) { const int b = wave * 8 + bb; float t = 0.f;
#pragma unroll
                for (int w8 = 0; w8 < 8; ++w8) t += part[(w8 * 16 + b) * 64 + lane];
                mo[b * 6144] = t + bias; } }
        __syncthreads();
    }
    for (int it = gw + MOD_ITEMS; it < MOD_ITEMS + 2 * TR_LAYER; it += NGW) {
        {
            int r = it - MOD_ITEMS; const int l = r / TR_LAYER; r -= l * TR_LAYER;
            if (r < TR_IN) { const int kb = r / 144, nb = r % 144, n0 = nb * 32, np = n0 + (lane & 31);
                const int sc = np < 1024 ? src_pair(np, 512) : (np < 2560 ? src_nat(np) : 2560 + src_pair(np - 2560, 1024));
                tr_item(p.w_in + (size_t)l * D * INC, INC, (bf16_t*)(p.ws + OFF_WIN) + (size_t)l * INC * D, D, kb * 64, kb * 64, n0, sc, scr, lane); continue; }
            r -= TR_IN;
            if (r < TR_MIX) { const int kb = r / 32, nb = r % 32, n0 = nb * 32, sc = src_nat(n0 + (lane & 31));
                const float* W = kb < 8 ? p.w_conv_out + (size_t)l * CW * D : p.w_att_out + (size_t)l * CW * D;
                tr_item(W, D, (bf16_t*)(p.ws + OFF_WMIX) + (size_t)l * D * D, D, kb * 64, (kb & 7) * 64, n0, sc, scr, lane); continue; }
            r -= TR_MIX;
            if (r < TR_O) { const int kb = r / 32, nb = r % 32, n0 = nb * 32, sc = src_nat(n0 + (lane & 31));
                tr_item(p.w_o + (size_t)l * D * D, D, (bf16_t*)(p.ws + OFF_WO) + (size_t)l * D * D, D, kb * 64, kb * 64, n0, sc, scr, lane); continue; }
            r -= TR_O;
            if (r < TR_F1) { const int kb = r / 176, nb = r % 176, n0 = nb * 32, sc = src_pair(n0 + (lane & 31), DFF);
                tr_item(p.w_ffn_in + (size_t)l * D * 2 * DFF, 2 * DFF, (bf16_t*)(p.ws + OFF_WF1) + (size_t)l * 2 * DFF * D, D, kb * 64, kb * 64, n0, sc, scr, lane); continue; }
            r -= TR_F1;
            { const int kb = r / 32, nb = r % 32, n0 = nb * 32, sc = src_nat(n0 + (lane & 31));
                tr_item(p.w_ffn_out + (size_t)l * DFF * D, D, (bf16_t*)(p.ws + OFF_WF2) + (size_t)l * D * DFF, DFF, kb * 64, kb * 64, n0, sc, scr, lane); }
        }
    }
}

DI void rowpass(const float* xin, const bf16_t* xinb, const bf16_t* y, const float* ss, const float* gate, const float* postg, float* xout, bf16_t* xoutb,
                const float* gnext, const float* scn, const float* shn, bf16_t* hout) {
    const int lane = threadIdx.x & 63, wave = threadIdx.x >> 6;
    const int gw = blockIdx.x * 8 + wave, NGW = gridDim.x * 8;
    constexpr int NR = 4, RPW = 32;
    for (int base = gw * RPW; base < M; base += NGW * RPW) {
        const int b = base >> 12;
        f32x4 c1[4], c2[4], c3[4];
#pragma unroll
        for (int j = 0; j < 4; ++j) { const int col = 4 * lane + 256 * j;
            c1[j] = y ? *(const f32x4*)(gate + b * 6144 + col) * *(const f32x4*)(postg + col) : (f32x4){0.f, 0.f, 0.f, 0.f};
            if (gnext) { c2[j] = *(const f32x4*)(gnext + col) * (1.0f + *(const f32x4*)(scn + b * 6144 + col)); c3[j] = *(const f32x4*)(shn + b * 6144 + col); }
            else { c2[j] = (f32x4){0.f, 0.f, 0.f, 0.f}; c3[j] = c2[j]; } }
        for (int r0 = 0; r0 < RPW; r0 += NR) {
            f32x4 v[NR][4]; u32x2 yw[NR][4]; float sq[NR];
#pragma unroll
            for (int q = 0; q < NR; ++q) { const size_t row = (size_t)(base + r0 + q);
#pragma unroll
                for (int j = 0; j < 4; ++j) {
                    if (xinb) { const u32x2 w = *(const u32x2*)(xinb + row * D + 4 * lane + 256 * j); v[q][j] = (f32x4){bf_lo(w.x), bf_hi(w.x), bf_lo(w.y), bf_hi(w.y)}; }
                    else v[q][j] = *(const f32x4*)(xin + row * D + 4 * lane + 256 * j); }
                if (y) { sq[q] = lane < 16 ? ss[row * 16 + lane] : 0.f;
#pragma unroll
                    for (int j = 0; j < 4; ++j) yw[q][j] = *(const u32x2*)(y + row * D + 4 * lane + 256 * j); } }
#pragma unroll
            for (int q = 0; q < NR; ++q) { const size_t row = (size_t)(base + r0 + q);
                if (y) {
                    const float rs = __builtin_amdgcn_rsqf(wave_sum(sq[q]) * (1.0f / D) + EPS);
#pragma unroll
                    for (int j = 0; j < 4; ++j) { const int col = 4 * lane + 256 * j; const u32x2 w = yw[q][j];
                        const f32x4 yv = {bf_lo(w.x), bf_hi(w.x), bf_lo(w.y), bf_hi(w.y)};
                        v[q][j] += (yv * rs) * c1[j];
                        if (xoutb) { u32x2 wo; wo.x = pk2(v[q][j].x, v[q][j].y); wo.y = pk2(v[q][j].z, v[q][j].w); *(u32x2*)(xoutb + row * D + col) = wo; }
                        else *(f32x4*)(xout + row * D + col) = v[q][j]; }
                }
                if (gnext) {
                    float s = 0.f;
#pragma unroll
                    for (int j = 0; j < 4; ++j) s += (v[q][j].x * v[q][j].x + v[q][j].y * v[q][j].y) + (v[q][j].z * v[q][j].z + v[q][j].w * v[q][j].w);
                    const float r = __builtin_amdgcn_rsqf(wave_sum(s) * (1.0f / D) + EPS);
#pragma unroll
                    for (int j = 0; j < 4; ++j) { const int col = 4 * lane + 256 * j;
                        const f32x4 hv = (v[q][j] * r) * c2[j] + c3[j];
                        u32x2 w; w.x = pk2(hv.x, hv.y); w.y = pk2(hv.z, hv.w);
                        *(u32x2*)(hout + row * D + col) = w; }
                }
            }
        }
    }
}

DI int crow(int r, int hi) { return (r & 3) + 8 * (r >> 2) + 4 * hi; }
#define MFMA32(a, b, c) __builtin_amdgcn_mfma_f32_32x32x16_bf16((a), (b), (c), 0, 0, 0)
typedef short v4i16_t __attribute__((ext_vector_type(4)));
DI s16x4 vtr(const LAS unsigned char* p) { return __builtin_bit_cast(s16x4, __builtin_amdgcn_ds_read_tr16_b64_v4i16((LAS v4i16_t*)p)); }
DI float softplus2(float z) {
    return fmaxf(z, 0.f) + __builtin_amdgcn_logf(1.0f + __builtin_amdgcn_exp2f(-fabsf(z)));
}
constexpr int KPITCH = 144, KVBUF = 64 * KPITCH;
DI void attn_wave(const bf16_t* QKV, const float* knp, bf16_t* OUT, LAS unsigned char* vl, int bh, int qb) {
    const int lane = threadIdx.x & 63, r32 = lane & 31, hi = lane >> 5;
    const int b = bh >> 3, h = bh & 7; const size_t rowbase = (size_t)b * SEQ;
    const int wq0 = qb * 32, tq = wq0 + r32;
    bf16x8 qf[4];
    { const bf16_t* qp = QKV + (rowbase + tq) * 1536 + h * 64 + hi * 8;
#pragma unroll
      for (int d0 = 0; d0 < 4; ++d0) qf[d0] = *(const bf16x8*)(qp + d0 * 16); }
    float qn;
    { float s = 0.f;
#pragma unroll
      for (int d0 = 0; d0 < 4; ++d0) { const u32x4 w = __builtin_bit_cast(u32x4, qf[d0]);
          s += bf_lo(w.x) * bf_lo(w.x) + bf_hi(w.x) * bf_hi(w.x) + bf_lo(w.y) * bf_lo(w.y) + bf_hi(w.y) * bf_hi(w.y) + bf_lo(w.z) * bf_lo(w.z) + bf_hi(w.z) * bf_hi(w.z) + bf_lo(w.w) * bf_lo(w.w) + bf_hi(w.w) * bf_hi(w.w); }
      auto rr = __builtin_amdgcn_permlane32_swap(__float_as_uint(s), __float_as_uint(s), false, false);
      qn = sqrtf(__uint_as_float(rr[0]) + __uint_as_float(rr[1])) * 1.001f; }
    float knpref;
    { const f32x2 kp = *(const f32x2*)(knp + ((size_t)bh * 64 + lane) * 2); float v = sqrtf(kp.x + kp.y) * 1.001f;
#pragma unroll
      for (int o = 1; o < 64; o <<= 1) { const float t = __shfl_up(v, o); if (lane >= o) v = fmaxf(v, t); }
      knpref = v; }
    f32x16 o0, o1;
#pragma unroll
    for (int i = 0; i < 16; ++i) { o0[i] = 0.f; o1[i] = 0.f; }
    float R = 0.f;
    int kb = (wq0 + 31) >> 6;
    const bf16_t* kbase = QKV + rowbase * 1536 + 512 + h * 64;
    bf16x8 ka[4], kc[4];
    { const bf16_t* kp = kbase + (size_t)(kb * 64 + r32) * 1536 + hi * 8;
#pragma unroll
      for (int d0 = 0; d0 < 4; ++d0) { ka[d0] = *(const bf16x8*)(kp + d0 * 16); kc[d0] = *(const bf16x8*)(kp + 32 * 1536 + d0 * 16); } }
    const int vq = (lane & 15) >> 2, vp = lane & 3, vblk = (lane >> 4) & 1;
    const unsigned vlane = (4 * hi + vq) * KPITCH + vblk * 32 + vp * 8;
    const unsigned vst = (lane >> 3) * KPITCH + (lane & 7) * 16;
    const float lomask = hi ? 0.f : 1.f;
    for (;;) {
        const int s0 = kb * 64;
        u32x4 vr[8];
        { const bf16_t* vp_ = kbase + 512 + (size_t)(s0 + (lane >> 3)) * 1536 + (lane & 7) * 8;
#pragma unroll
          for (int i = 0; i < 8; ++i) vr[i] = *(const u32x4*)(vp_ + (size_t)(8 * i) * 1536); }
        f32x16 z0, z1;
#pragma unroll
        for (int i = 0; i < 16; ++i) { z0[i] = 0.f; z1[i] = 0.f; }
#pragma unroll
        for (int d0 = 0; d0 < 4; ++d0) { z0 = MFMA32(ka[d0], qf[d0], z0); z1 = MFMA32(kc[d0], qf[d0], z1); }
        if (kb > 0) { const bf16_t* kp = kbase + (size_t)((kb - 1) * 64 + r32) * 1536 + hi * 8;
#pragma unroll
            for (int d0 = 0; d0 < 4; ++d0) { ka[d0] = *(const bf16x8*)(kp + d0 * 16); kc[d0] = *(const bf16x8*)(kp + 32 * 1536 + d0 * 16); } }
        if (s0 + 63 >= wq0) {
#pragma unroll
            for (int i = 0; i < 16; ++i) { const int kv = s0 + crow(i, hi); if (kv >= tq) z0[i] = -INFINITY; if (kv + 32 >= tq) z1[i] = -INFINITY; }
        }
        f32x16 c0, c1; float Glo[8], Ghi[8];
#pragma unroll
        for (int g = 0; g < 4; ++g) {
            float a3 = softplus2(z0[4 * g + 3]), a2 = softplus2(z0[4 * g + 2]) + a3, a1 = softplus2(z0[4 * g + 1]) + a2, a0 = softplus2(z0[4 * g]) + a1;
            c0[4 * g + 3] = a3; c0[4 * g + 2] = a2; c0[4 * g + 1] = a1; c0[4 * g] = a0;
            auto rr = __builtin_amdgcn_permlane32_swap(__float_as_uint(a0), __float_as_uint(a0), false, false);
            Glo[g] = __uint_as_float(rr[0]); Ghi[g] = __uint_as_float(rr[1]);
            float b3 = softplus2(z1[4 * g + 3]), b2 = softplus2(z1[4 * g + 2]) + b3, b1 = softplus2(z1[4 * g + 1]) + b2, b0 = softplus2(z1[4 * g]) + b1;
            c1[4 * g + 3] = b3; c1[4 * g + 2] = b2; c1[4 * g + 1] = b1; c1[4 * g] = b0;
            auto ss_ = __builtin_amdgcn_permlane32_swap(__float_as_uint(b0), __float_as_uint(b0), false, false);
            Glo[4 + g] = __uint_as_float(ss_[0]); Ghi[4 + g] = __uint_as_float(ss_[1]);
        }
        float run = R;
        u32x4 pf[2][2];
#pragma unroll
        for (int c = 7; c >= 0; --c) {
            const float base = __builtin_fmaf(Ghi[c], lomask, run);
            const int g = c & 3;
            float a[4];
            if (c >= 4) {
#pragma unroll
                for (int j = 0; j < 4; ++j) a[j] = __builtin_amdgcn_exp2f(z1[4 * g + j] - (c1[4 * g + j] + base));
                if (g & 1) { pf[1][g >> 1].z = pk2(a[0], a[1]); pf[1][g >> 1].w = pk2(a[2], a[3]); } else { pf[1][g >> 1].x = pk2(a[0], a[1]); pf[1][g >> 1].y = pk2(a[2], a[3]); }
            } else {
#pragma unroll
                for (int j = 0; j < 4; ++j) a[j] = __builtin_amdgcn_exp2f(z0[4 * g + j] - (c0[4 * g + j] + base));
                if (g & 1) { pf[0][g >> 1].z = pk2(a[0], a[1]); pf[0][g >> 1].w = pk2(a[2], a[3]); } else { pf[0][g >> 1].x = pk2(a[0], a[1]); pf[0][g >> 1].y = pk2(a[2], a[3]); }
            }
            run += Glo[c] + Ghi[c];
        }
        R = run;
#pragma unroll
        for (int i = 0; i < 8; ++i) *(LAS u32x4*)(vl + vst + i * 8 * KPITCH) = vr[i];
#pragma unroll
        for (int kt = 0; kt < 2; ++kt)
#pragma unroll
            for (int s = 0; s < 2; ++s) {
                const LAS unsigned char* vb = vl + vlane + (32 * kt + 16 * s) * KPITCH;
                const s16x4 l0 = vtr(vb), h0 = vtr(vb + 8 * KPITCH), l1 = vtr(vb + 64), h1 = vtr(vb + 64 + 8 * KPITCH);
                const bf16x8 v0 = __builtin_shufflevector(l0, h0, 0, 1, 2, 3, 4, 5, 6, 7), v1 = __builtin_shufflevector(l1, h1, 0, 1, 2, 3, 4, 5, 6, 7);
                const bf16x8 pb = __builtin_bit_cast(bf16x8, pf[kt][s]);
                o0 = MFMA32(v0, pb, o0); o1 = MFMA32(v1, pb, o1);
            }
        if (kb == 0) break;
        const float kbound = __uint_as_float(__builtin_amdgcn_readlane(__float_as_uint(knpref), kb - 1));
        if (__all((R - qn * kbound) > 160.f)) break;
        --kb;
    }
    bf16_t* op = OUT + (rowbase + tq) * D + CW + h * 64 + 4 * hi;
#pragma unroll
    for (int g = 0; g < 4; ++g) {
        u32x2 w0, w1; w0.x = pk2(o0[4 * g], o0[4 * g + 1]); w0.y = pk2(o0[4 * g + 2], o0[4 * g + 3]); w1.x = pk2(o1[4 * g], o1[4 * g + 1]); w1.y = pk2(o1[4 * g + 2], o1[4 * g + 3]);
        *(u32x2*)(op + 8 * g) = w0; *(u32x2*)(op + 32 + 8 * g) = w1;
    }
}

constexpr int ATT_BUF = 4 * KVBUF;
DI void attn_block(const bf16_t* QKV, const float* knp, bf16_t* OUT, LAS unsigned char* lds, int b, int hp, int qt) {
    const int tid = threadIdx.x, lane = tid & 63, r32 = lane & 31, hi = lane >> 5; const int wid = __builtin_amdgcn_readfirstlane(tid >> 6);
    const int hsel = wid >> 2, h = 2 * hp + hsel, bh = b * 8 + h; const size_t rowbase = (size_t)b * SEQ;
    const int q0 = qt * 128, wq0 = q0 + (wid & 3) * 32, tq = wq0 + r32;
    bf16x8 qf[4];
    { const bf16_t* qp = QKV + (rowbase + tq) * 1536 + h * 64 + hi * 8;
#pragma unroll
      for (int d0 = 0; d0 < 4; ++d0) qf[d0] = *(const bf16x8*)(qp + d0 * 16); }
    float qn;
    { float s = 0.f;
#pragma unroll
      for (int d0 = 0; d0 < 4; ++d0) { const u32x4 w = __builtin_bit_cast(u32x4, qf[d0]);
          s += bf_lo(w.x) * bf_lo(w.x) + bf_hi(w.x) * bf_hi(w.x) + bf_lo(w.y) * bf_lo(w.y) + bf_hi(w.y) * bf_hi(w.y) + bf_lo(w.z) * bf_lo(w.z) + bf_hi(w.z) * bf_hi(w.z) + bf_lo(w.w) * bf_lo(w.w) + bf_hi(w.w) * bf_hi(w.w); }
      auto rr = __builtin_amdgcn_permlane32_swap(__float_as_uint(s), __float_as_uint(s), false, false);
      qn = sqrtf(__uint_as_float(rr[0]) + __uint_as_float(rr[1])) * 1.001f; }
    float knpref;
    { const f32x2 kp = *(const f32x2*)(knp + ((size_t)bh * 64 + lane) * 2); float v = sqrtf(kp.x + kp.y) * 1.001f;
#pragma unroll
      for (int o = 1; o < 64; o <<= 1) { const float t = __shfl_up(v, o); if (lane >= o) v = fmaxf(v, t); }
      knpref = v; }
    f32x16 o0, o1;
#pragma unroll
    for (int i = 0; i < 16; ++i) { o0[i] = 0.f; o1[i] = 0.f; }
    float R = 0.f;
    const int nkb = (q0 + 128) / 64;
    const int srow = tid >> 3, sch = tid & 7;
    const bf16_t* sg = QKV + (rowbase + srow) * 1536 + 512 + (2 * hp) * 64 + sch * 8;
    const unsigned soff = srow * KPITCH + sch * 16;
    LAS unsigned* fl = (LAS unsigned*)(lds + 2 * ATT_BUF);
    u32x4 st0, st1, st2, st3;
#define ATT_LOAD(kb_) do { const bf16_t* g_ = sg + (size_t)(kb_) * 64 * 1536; st0 = *(const u32x4*)g_; st1 = *(const u32x4*)(g_ + 512); st2 = *(const u32x4*)(g_ + 64); st3 = *(const u32x4*)(g_ + 576); } while (0)
#define ATT_STORE(buf_) do { LAS unsigned char* d_ = lds + (buf_) * ATT_BUF + soff; *(LAS u32x4*)d_ = st0; *(LAS u32x4*)(d_ + KVBUF) = st1; *(LAS u32x4*)(d_ + 2 * KVBUF) = st2; *(LAS u32x4*)(d_ + 3 * KVBUF) = st3; } while (0)
    ATT_LOAD(nkb - 1); ATT_STORE(0);
    __syncthreads();
    const int vq = (lane & 15) >> 2, vp = lane & 3, vblk = (lane >> 4) & 1;
    const unsigned vlane = (4 * hi + vq) * KPITCH + vblk * 32 + vp * 8;
    const float lomask = hi ? 0.f : 1.f;
    for (int it = 0; it < nkb; ++it) {
        const int kb = nkb - 1 - it, cur = it & 1, s0 = kb * 64;
        const bool more = (it + 1 < nkb);
        if (more) ATT_LOAD(kb - 1);
        if (s0 < wq0 + 32) {
            const LAS unsigned char* Kb = lds + cur * ATT_BUF + hsel * (2 * KVBUF); const LAS unsigned char* Vb = Kb + KVBUF;
            f32x16 z0, z1;
#pragma unroll
            for (int i = 0; i < 16; ++i) { z0[i] = 0.f; z1[i] = 0.f; }
#pragma unroll
            for (int d0 = 0; d0 < 4; ++d0) {
                const bf16x8 ka = *(const LAS bf16x8*)(Kb + r32 * KPITCH + d0 * 32 + hi * 16);
                const bf16x8 kc = *(const LAS bf16x8*)(Kb + (32 + r32) * KPITCH + d0 * 32 + hi * 16);
                z0 = MFMA32(ka, qf[d0], z0); z1 = MFMA32(kc, qf[d0], z1);
            }
            if (s0 + 63 >= wq0) {
#pragma unroll
                for (int i = 0; i < 16; ++i) { const int kv = s0 + crow(i, hi); if (kv >= tq) z0[i] = -INFINITY; if (kv + 32 >= tq) z1[i] = -INFINITY; }
            }
            f32x16 c0, c1; float Glo[8], Ghi[8];
#pragma unroll
            for (int g = 0; g < 4; ++g) {
                float a3 = softplus2(z0[4 * g + 3]), a2 = softplus2(z0[4 * g + 2]) + a3, a1 = softplus2(z0[4 * g + 1]) + a2, a0 = softplus2(z0[4 * g]) + a1;
                c0[4 * g + 3] = a3; c0[4 * g + 2] = a2; c0[4 * g + 1] = a1; c0[4 * g] = a0;
                auto rr = __builtin_amdgcn_permlane32_swap(__float_as_uint(a0), __float_as_uint(a0), false, false);
                Glo[g] = __uint_as_float(rr[0]); Ghi[g] = __uint_as_float(rr[1]);
                float b3 = softplus2(z1[4 * g + 3]), b2 = softplus2(z1[4 * g + 2]) + b3, b1 = softplus2(z1[4 * g + 1]) + b2, b0 = softplus2(z1[4 * g]) + b1;
                c1[4 * g + 3] = b3; c1[4 * g + 2] = b2; c1[4 * g + 1] = b1; c1[4 * g] = b0;
                auto ss_ = __builtin_amdgcn_permlane32_swap(__float_as_uint(b0), __float_as_uint(b0), false, false);
                Glo[4 + g] = __uint_as_float(ss_[0]); Ghi[4 + g] = __uint_as_float(ss_[1]);
            }
            float run = R;
            u32x4 pf[2][2];
#pragma unroll
            for (int c = 7; c >= 0; --c) {
                const float base = __builtin_fmaf(Ghi[c], lomask, run);
                const int g = c & 3;
                float a[4];
                if (c >= 4) {
#pragma unroll
                    for (int j = 0; j < 4; ++j) a[j] = __builtin_amdgcn_exp2f(z1[4 * g + j] - (c1[4 * g + j] + base));
                    if (g & 1) { pf[1][g >> 1].z = pk2(a[0], a[1]); pf[1][g >> 1].w = pk2(a[2], a[3]); } else { pf[1][g >> 1].x = pk2(a[0], a[1]); pf[1][g >> 1].y = pk2(a[2], a[3]); }
                } else {
#pragma unroll
                    for (int j = 0; j < 4; ++j) a[j] = __builtin_amdgcn_exp2f(z0[4 * g + j] - (c0[4 * g + j] + base));
                    if (g & 1) { pf[0][g >> 1].z = pk2(a[0], a[1]); pf[0][g >> 1].w = pk2(a[2], a[3]); } else { pf[0][g >> 1].x = pk2(a[0], a[1]); pf[0][g >> 1].y = pk2(a[2], a[3]); }
                }
                run += Glo[c] + Ghi[c];
            }
            R = run;
#pragma unroll
            for (int kt = 0; kt < 2; ++kt)
#pragma unroll
                for (int s = 0; s < 2; ++s) {
                    const LAS unsigned char* vb = Vb + vlane + (32 * kt + 16 * s) * KPITCH;
                    const s16x4 l0 = vtr(vb), h0 = vtr(vb + 8 * KPITCH), l1 = vtr(vb + 64), h1 = vtr(vb + 64 + 8 * KPITCH);
                    const bf16x8 v0 = __builtin_shufflevector(l0, h0, 0, 1, 2, 3, 4, 5, 6, 7), v1 = __builtin_shufflevector(l1, h1, 0, 1, 2, 3, 4, 5, 6, 7);
                    const bf16x8 pb = __builtin_bit_cast(bf16x8, pf[kt][s]);
                    o0 = MFMA32(v0, pb, o0); o1 = MFMA32(v1, pb, o1);
                }
        }
        if (more) { ATT_STORE(cur ^ 1);
            const float kbound = __uint_as_float(__builtin_amdgcn_readlane(__float_as_uint(knpref), kb - 1));
            const bool ldone = (R - qn * kbound) > 160.f;
            if (lane == 0) fl[cur * 8 + wid] = __all(ldone) ? 1u : 0u; }
        __syncthreads();
        if (more) { const u32x4 fa = *(const LAS u32x4*)(fl + cur * 8), fb = *(const LAS u32x4*)(fl + cur * 8 + 4);
            if ((fa.x & fa.y & fa.z & fa.w & fb.x & fb.y & fb.z & fb.w) != 0u) break; }
    }
    __syncthreads();
#undef ATT_LOAD
#undef ATT_STORE
    bf16_t* op = OUT + (rowbase + tq) * D + CW + h * 64 + 4 * hi;
#pragma unroll
    for (int g = 0; g < 4; ++g) {
        u32x2 w0, w1; w0.x = pk2(o0[4 * g], o0[4 * g + 1]); w0.y = pk2(o0[4 * g + 2], o0[4 * g + 3]); w1.x = pk2(o1[4 * g], o1[4 * g + 1]); w1.y = pk2(o1[4 * g + 2], o1[4 * g + 3]);
        *(u32x2*)(op + 8 * g) = w0; *(u32x2*)(op + 32 + 8 * g) = w1;
    }
}

constexpr int CT = 64, CROWS = 96, CW_OFF = CROWS * 1024, CWROWS = 36;
DI void conv_load_w(const float* cw, LAS unsigned char* lds) {
    f32x2 wv[CWROWS * CW / 2 / 512];
#pragma unroll
    for (int k = 0; k < CWROWS * CW / 2 / 512; ++k) { const int i = threadIdx.x + 512 * k; wv[k] = (f32x2){0.f, 0.f}; if (i < CK * CW / 2) wv[k] = *(const f32x2*)(cw + 2 * i); }
#pragma unroll
    for (int k = 0; k < CWROWS * CW / 2 / 512; ++k) { const int i = threadIdx.x + 512 * k; *(LAS unsigned*)(lds + CW_OFF + 4 * i) = pk2(wv[k].x, wv[k].y); }
}
DI void unpack8(const u32x4 w, f32x2 (&o)[4]) { o[0] = (f32x2){bf_lo(w.x), bf_hi(w.x)}; o[1] = (f32x2){bf_lo(w.y), bf_hi(w.y)}; o[2] = (f32x2){bf_lo(w.z), bf_hi(w.z)}; o[3] = (f32x2){bf_lo(w.w), bf_hi(w.w)}; }
DI void conv_item(const bf16_t* U, bf16_t* OUT, const float* cb, const float* lg, const float* lb, LAS unsigned char* lds, int item) {
    const int tid = threadIdx.x, lane = tid & 63, wave = tid >> 6;
    const int b = item >> 6, t0 = (item & 63) * CT; const size_t rowbase = (size_t)b * SEQ;
    __syncthreads();
    { u32x4 tv[CROWS * 64 / 512];
#pragma unroll
      for (int k = 0; k < CROWS * 64 / 512; ++k) { const int i = tid + 512 * k, r = i >> 6, c16 = i & 63, s = t0 - (CK - 1) + r;
          tv[k] = (u32x4){0u, 0u, 0u, 0u}; if (s >= 0 && r < CT + CK - 1) tv[k] = *(const u32x4*)(U + (rowbase + s) * CW + c16 * 8); }
#pragma unroll
      for (int k = 0; k < CROWS * 64 / 512; ++k) { const int i = tid + 512 * k; *(LAS u32x4*)(lds + (i >> 6) * 1024 + (i & 63) * 16) = tv[k]; } }
    __syncthreads();
    f32x2 bias[4], g8[4], b8[4];
#pragma unroll
    for (int j = 0; j < 4; ++j) { bias[j] = *(const f32x2*)(cb + lane * 8 + 2 * j); g8[j] = *(const f32x2*)(lg + lane * 8 + 2 * j); b8[j] = *(const f32x2*)(lb + lane * 8 + 2 * j); }
    for (int grp = 0; grp < 2; ++grp) {
        const int t4 = wave * 8 + grp * 4;
        f32x2 acc[4][4], wv[4][4];
#pragma unroll
        for (int i = 0; i < 4; ++i)
#pragma unroll
            for (int j = 0; j < 4; ++j) { acc[i][j] = bias[j]; wv[i][j] = (f32x2){0.f, 0.f}; }
#pragma unroll 1
        for (int rb = 0; rb < CWROWS; rb += 4) {
#pragma unroll
            for (int q = 0; q < 4; ++q) {
                f32x2 u8[4]; unpack8(*(const LAS u32x4*)(lds + (t4 + rb + q) * 1024 + lane * 16), u8);
                unpack8(*(const LAS u32x4*)(lds + CW_OFF + (rb + q) * 1024 + lane * 16), wv[q]);
#pragma unroll
                for (int i = 0; i < 4; ++i)
#pragma unroll
                    for (int j = 0; j < 4; ++j) acc[i][j] = acc[i][j] + wv[(q - i) & 3][j] * u8[j];
            }
        }
#pragma unroll
        for (int i = 0; i < 4; ++i) {
            float s = 0.f;
#pragma unroll
            for (int j = 0; j < 4; ++j) s += acc[i][j].x + acc[i][j].y;
            const float mean = wave_sum(s) * (1.0f / CW); float s2 = 0.f;
#pragma unroll
            for (int j = 0; j < 4; ++j) { acc[i][j] = acc[i][j] - mean; s2 += acc[i][j].x * acc[i][j].x + acc[i][j].y * acc[i][j].y; }
            const float rstd = __builtin_amdgcn_rsqf(wave_sum(s2) * (1.0f / CW) + EPS);
            unsigned o[4];
#pragma unroll
            for (int j = 0; j < 4; ++j) { const f32x2 yv = acc[i][j] * rstd * g8[j] + b8[j]; o[j] = pk2(yv.x * fast_sigmoid(yv.x), yv.y * fast_sigmoid(yv.y)); }
            u32x4 w; w.x = o[0]; w.y = o[1]; w.z = o[2]; w.w = o[3];
            *(u32x4*)(OUT + (rowbase + t0 + t4 + i) * D + lane * 8) = w;
        }
    }
}

#ifndef MK_CG_ALL
#define MK_CG_ALL 0
#endif
#define PH_IN(k) (lo <= (k) && (k) < hi)
#define XB_TMO      128
#define XB_XCNT(j)  (256  + 64 * (j))
#define XB_XSUB(j)  (1280 + 64 * (j))
#define XB_XGEN(j)  (2304 + 64 * (j))
#define XB_TOP      3328
#define XB_TOPGEN   3392
#define XCD_BAR_WORDS 3456
#define XB_SPIN_CAP (1u << 18)
DI unsigned xb_ld(unsigned* p)              { return __hip_atomic_load(p, __ATOMIC_RELAXED, __HIP_MEMORY_SCOPE_AGENT); }
DI unsigned xb_add(unsigned* p, unsigned v) { return __hip_atomic_fetch_add(p, v, __ATOMIC_RELAXED, __HIP_MEMORY_SCOPE_AGENT); }
DI unsigned xb_xcc_id() { return (unsigned)__builtin_amdgcn_s_getreg((3 << 11) | 20) & 0xFu; }
#define XB_SPIN(cond, bar) do { unsigned _sp = 0; while (cond) { __builtin_amdgcn_s_sleep(1); \
    if ((++_sp & 255u) == 0u) { if (xb_ld(&(bar)[XB_TMO])) break; if (_sp > XB_SPIN_CAP) { atomicAdd(&(bar)[XB_TMO], 1u); break; } } } } while (0)
struct XcdBarrier { unsigned* bar; unsigned x; volatile LAS unsigned* st; };
DI XcdBarrier xcd_barrier_post(unsigned* bar, volatile LAS unsigned* st) {
    XcdBarrier b; b.bar = bar; b.x = xb_xcc_id(); b.st = st;
    if (threadIdx.x == 0) (void)xb_add(&bar[XB_XCNT(b.x)], 1u);
    return b;
}
DI void xcd_barrier_complete(unsigned* bar, unsigned x, unsigned& nloc, unsigned& nx) {
    const unsigned G = gridDim.x * gridDim.y * gridDim.z;
    unsigned sum, cnt, mine, sp = 0u;
    for (;;) {
        sum = 0u; cnt = 0u; mine = 0u;
#pragma unroll
        for (unsigned j = 0; j < 16; ++j) { const unsigned c = xb_ld(&bar[XB_XCNT(j)]); sum += c; cnt += (c > 0u) ? 1u : 0u; mine = (j == x) ? c : mine; }
        if (sum == G) break;
        __builtin_amdgcn_s_sleep(1);
        if ((++sp & 255u) == 0u) { if (xb_ld(&bar[XB_TMO])) break; if (sp > XB_SPIN_CAP) { atomicAdd(&bar[XB_TMO], 1u); break; } }
    }
    nloc = mine > 0u ? mine : 1u; nx = cnt > 0u ? cnt : 1u;
}
DI void xcd_barrier(const XcdBarrier& b) {
    asm volatile("s_waitcnt vmcnt(0)" ::: "memory");
    __syncthreads();
    if (threadIdx.x == 0) {
        unsigned* bar = b.bar;
        __builtin_amdgcn_s_waitcnt(0);
        unsigned nloc = b.st[0], nx = b.st[1];
        if (nloc == 0u) { xcd_barrier_complete(bar, b.x, nloc, nx); b.st[0] = nloc; b.st[1] = nx; }
        const unsigned old = xb_add(&bar[XB_XSUB(b.x)], 1u);
        const unsigned gen = old / nloc;
        if (old + 1u == (gen + 1u) * nloc) {
            __builtin_amdgcn_fence(__ATOMIC_RELEASE, "agent");
            asm volatile("s_waitcnt vmcnt(0)" ::: "memory");
            const unsigned og = xb_add(&bar[XB_TOP], 1u);
            const unsigned tg = og / nx;
            if (og + 1u == (tg + 1u) * nx) xb_add(&bar[XB_TOPGEN], 1u);
            else XB_SPIN(xb_ld(&bar[XB_TOPGEN]) == tg, bar);
            __builtin_amdgcn_fence(__ATOMIC_ACQUIRE, "agent");
            xb_add(&bar[XB_XGEN(b.x)], 1u);
            asm volatile("s_waitcnt vmcnt(0)" ::: "memory");
        } else {
            XB_SPIN(xb_ld(&bar[XB_XGEN(b.x)]) == gen, bar);
            __builtin_amdgcn_fence(__ATOMIC_ACQUIRE, "agent");
            asm volatile("s_waitcnt vmcnt(0)" ::: "memory");
        }
    }
    __syncthreads();
}
#ifndef MK_DUP
#define MK_DUP 0
#endif
#define PH_SEAM(k) do { if (PH_IN(k) && PH_IN((k) + 1)) { if (MK_CG_ALL || p.out == nullptr) grid.sync(); else xcd_barrier(bar);     } } while (0)
template <int L>
DI void layer_phases(const Params& p, LAS unsigned char* lds, const int lo, const int hi, cg::grid_group& grid, const XcdBarrier& bar) {
    unsigned char* ws = p.ws;
    float* mod = (float*)(ws + OFF_MOD); float* ssb = (float*)(ws + OFF_SS);
    bf16_t* H = (bf16_t*)(ws + OFF_H); bf16_t* MIX = (bf16_t*)(ws + OFF_MIX); bf16_t* XB = (bf16_t*)(ws + OFF_XB);
    bf16_t* Ub = (bf16_t*)(ws + OFF_U); bf16_t* QKV = (bf16_t*)(ws + OFF_QKV); bf16_t* RATIO = (bf16_t*)(ws + OFF_RATIO); bf16_t* SGA = (bf16_t*)(ws + OFF_SGA); bf16_t* HID = (bf16_t*)(ws + OFF_HID);
    const float* modl = mod + (size_t)L * NB * 6144;
    constexpr int P0 = 2 + 8 * L;
    if (PH_IN(P0)) { pg8::StaticOrder S; EpiIn E{Ub, QKV, RATIO, SGA, (float*)(ws + OFF_KN)}; S.init(M, INC, gridDim.x, blockIdx.x);
        for (int rep = 0; rep < ((L == 0 && (MK_DUP & 4)) ? 2 : 1); ++rep) pg8::gemm_phase(lds, pg8::Gemm{H, (const bf16_t*)(ws + OFF_WIN) + (size_t)L * INC * D, M, INC, D}, S, E); }
    PH_SEAM(P0);
    if (PH_IN(P0 + 1)) for (int rep = 0; rep < ((L == 0 && (MK_DUP & 2)) ? 2 : 1); ++rep) {
        __syncthreads();
        const int vb = (gridDim.x % 8 == 0) ? (int)((blockIdx.x % 8) * (gridDim.x / 8) + blockIdx.x / 8) : (int)blockIdx.x;
        for (int it = vb; it < 2048; it += gridDim.x) attn_block(QKV, (const float*)(ws + OFF_KN), MIX, lds, it >> 7, (it >> 5) & 3, it & 31);
        conv_load_w(p.conv_w + (size_t)L * CK * CW, lds);
        for (int it = vb; it < 1024; it += gridDim.x)
            conv_item(Ub, MIX, p.conv_b + L * CW, p.conv_ln_g + L * CW, p.conv_ln_b + L * CW, lds, it);
    }
    PH_SEAM(P0 + 1);
    if (PH_IN(P0 + 2)) { pg8::StaticOrder S; EpiMix E{RATIO, SGA, H}; S.init(M, D, gridDim.x, blockIdx.x);
        for (int rep = 0; rep < ((L == 0 && (MK_DUP & 4)) ? 2 : 1); ++rep) pg8::gemm_phase(lds, pg8::Gemm{MIX, (const bf16_t*)(ws + OFF_WMIX) + (size_t)L * D * D, M, D, D}, S, E); }
    PH_SEAM(P0 + 2);
    if (PH_IN(P0 + 3)) { pg8::StaticOrder S; EpiY E{MIX, ssb + (size_t)(2 * L) * M * 16}; S.init(M, D, gridDim.x, blockIdx.x);
        for (int rep = 0; rep < ((L == 0 && (MK_DUP & 4)) ? 2 : 1); ++rep) pg8::gemm_phase(lds, pg8::Gemm{H, (const bf16_t*)(ws + OFF_WO) + (size_t)L * D * D, M, D, D}, S, E); }
    PH_SEAM(P0 + 3);
    if (PH_IN(P0 + 4)) rowpass(p.x, L == 0 ? nullptr : XB, MIX, ssb + (size_t)(2 * L) * M * 16, modl + 2048, p.post_mix_g + L * D, nullptr, XB, p.pre_ffn_g + L * D, modl + 4096, modl + 3072, H);
    PH_SEAM(P0 + 4);
    if (PH_IN(P0 + 5)) { pg8::StaticOrder S; EpiF1 E{HID}; S.init(M, 2 * DFF, gridDim.x, blockIdx.x);
        for (int rep = 0; rep < ((L == 0 && (MK_DUP & 4)) ? 2 : 1); ++rep) pg8::gemm_phase(lds, pg8::Gemm{H, (const bf16_t*)(ws + OFF_WF1) + (size_t)L * 2 * DFF * D, M, 2 * DFF, D}, S, E); }
    PH_SEAM(P0 + 5);
    if (PH_IN(P0 + 6)) { pg8::StaticOrder S; EpiY E{MIX, ssb + (size_t)(2 * L + 1) * M * 16}; S.init(M, D, gridDim.x, blockIdx.x);
        for (int rep = 0; rep < ((L == 0 && (MK_DUP & 4)) ? 2 : 1); ++rep) pg8::gemm_phase(lds, pg8::Gemm{HID, (const bf16_t*)(ws + OFF_WF2) + (size_t)L * D * DFF, M, D, DFF}, S, E); }
    PH_SEAM(P0 + 6);
    if (PH_IN(P0 + 7)) { constexpr bool lastl = (L == DEPTH - 1); const float* modn = modl + (size_t)NB * 6144;
        rowpass(nullptr, XB, MIX, ssb + (size_t)(2 * L + 1) * M * 16, modl + 5120, p.post_ffn_g + L * D, p.out, lastl ? nullptr : XB,
                lastl ? nullptr : p.pre_mix_g + (lastl ? 0 : L + 1) * D, modn + 1024, modn, H); }
    if (L + 1 < DEPTH) PH_SEAM(P0 + 7);
}

__global__ __launch_bounds__(512, 2) void fwd_megakernel(Params p) {
    extern __shared__ __attribute__((aligned(16))) unsigned char shm[];
    LAS unsigned char* lds = (LAS unsigned char*)shm;
    cg::grid_group grid = cg::this_grid();
    const int lo = p.ph_lo, hi = p.ph_hi;
    volatile LAS unsigned* st = (volatile LAS unsigned*)(lds + 135168);
    if (threadIdx.x < 4) st[threadIdx.x] = 0u;
    __syncthreads();
    XcdBarrier bar; bar.bar = (unsigned*)(p.ws + OFF_BAR); bar.x = 0; bar.st = st;
    if (hi - lo > 2) bar = xcd_barrier_post((unsigned*)(p.ws + OFF_BAR), st);
    if (PH_IN(0)) { phase0(p, lds); if (MK_DUP & 1) { __syncthreads(); phase0(p, lds); } }
    PH_SEAM(0);
    if (PH_IN(1)) { float* mod = (float*)(p.ws + OFF_MOD); for (int rep = 0; rep < ((MK_DUP & 1) ? 2 : 1); ++rep) rowpass(p.x, nullptr, nullptr, nullptr, nullptr, nullptr, nullptr, nullptr, p.pre_mix_g, mod + 1024, mod, (bf16_t*)(p.ws + OFF_H)); }
    PH_SEAM(1);
    layer_phases<0>(p, lds, lo, hi, grid, bar);
    layer_phases<1>(p, lds, lo, hi, grid, bar);
}


#ifndef MK_CHECK
#define MK_CHECK 0
#endif
#if MK_CHECK
DI float bfr(float x) { return bf_lo(pk2(x, 0.f)); }
DI float ldbf(const bf16_t* p) { return __uint_as_float(((unsigned)*p) << 16); }
DI unsigned hsh(unsigned x) { x ^= x >> 16; x *= 0x7feb352du; x ^= x >> 15; x *= 0x846ca68bu; x ^= x >> 16; return x; }
DI void diag_max(const Params& p, int stage, float got, float ref) {
    float e = fabsf(got - ref) / (fabsf(ref) + 0.05f); if (!(e == e)) e = 1e9f;
    atomicMax((unsigned*)(p.ws + OFF_DIAG) + stage, __float_as_uint(e));
}
DI float dotA(const bf16_t* a, const float* w, int ldw, int K) { float s = 0.f; for (int k = 0; k < K; ++k) s += ldbf(a + k) * bfr(w[(size_t)k * ldw]); return s; }
DI float sigm(float x) { return 1.0f / (1.0f + expf(-x)); }
__global__ void chk_kernel(Params p, int stage) {
    const unsigned id = blockIdx.x * blockDim.x + threadIdx.x; const unsigned h1 = hsh(id * 2654435761u + stage * 977u), h2 = hsh(h1 + 12345u);
    unsigned char* ws = p.ws; const float* mod = (const float*)(ws + OFF_MOD); const float* ssb = (const float*)(ws + OFF_SS);
    const bf16_t* H = (const bf16_t*)(ws + OFF_H); const bf16_t* MIX = (const bf16_t*)(ws + OFF_MIX); const bf16_t* Ub = (const bf16_t*)(ws + OFF_U); const bf16_t* QKV = (const bf16_t*)(ws + OFF_QKV);
    const bf16_t* RATIO = (const bf16_t*)(ws + OFF_RATIO); const bf16_t* SGA = (const bf16_t*)(ws + OFF_SGA); const bf16_t* HID = (const bf16_t*)(ws + OFF_HID);
    int row = h1 % M; if ((id & 7) == 0) row = (row & ~4095) + (h2 % 40); const int b = row >> 12;
    if (stage == 1) { const int l = id & 1, bb = (id >> 1) & 15, col = h1 % 6144; float s = p.ada_b[l * 6144 + col];
        for (int k = 0; k < D; ++k) { const float c = p.c[bb * D + k]; s += c * sigm(c) * p.ada_w[((size_t)l * D + k) * 6144 + col]; }
        diag_max(p, 1, mod[(l * NB + bb) * 6144 + col], s); }
    if (stage == 2) { float q = 0.f; for (int k = 0; k < D; ++k) { const float v = p.x[(size_t)row * D + k]; q += v * v; }
        const float rs = 1.0f / sqrtf(q / D + EPS); const int col = h2 % D;
        const float ref = p.x[(size_t)row * D + col] * rs * p.pre_mix_g[col] * (1.0f + mod[b * 6144 + 1024 + col]) + mod[b * 6144 + col];
        diag_max(p, 2, ldbf(H + (size_t)row * D + col), ref); }
    if (stage == 3) { const bf16_t* a = H + (size_t)row * D; const int t = id & 3;
        if (t == 0) { const int ch = h2 % CW; const float v = dotA(a, p.w_in + ch, INC, D), g = dotA(a, p.w_in + 512 + ch, INC, D); diag_max(p, 3, ldbf(Ub + (size_t)row * CW + ch), v * sigm(g)); }
        else if (t == 1) { const int c = h2 % 1536; const float v = dotA(a, p.w_in + 1024 + c, INC, D) * (c < 512 ? 0.125f * LOG2E : 1.0f); diag_max(p, 3, ldbf(QKV + (size_t)row * 1536 + c), v); }
        else { const int ch = h2 % D; const float gc = dotA(a, p.w_in + 2560 + ch, INC, D), ga = dotA(a, p.w_in + 3584 + ch, INC, D);
            if (t == 2) diag_max(p, 3, ldbf(RATIO + (size_t)row * D + ch), sigm(gc) / sigm(ga)); else diag_max(p, 3, ldbf(SGA + (size_t)row * D + ch), sigm(ga)); } }
    if (stage == 4) { const int s0 = row & 4095; float s1 = 0.f, s2 = 0.f; const int chs = h2 % CW; float vs = 0.f;
        for (int ch = 0; ch < CW; ++ch) { float a = p.conv_b[ch];
            for (int k = 0; k < CK; ++k) { const int s = s0 - 30 + k; if (s >= 0) a += bfr(p.conv_w[k * CW + ch]) * ldbf(Ub + ((size_t)(row - s0 + s)) * CW + ch); }
            s1 += a; s2 += a * a; if (ch == chs) vs = a; }
        const float mean = s1 / CW, var = s2 / CW - mean * mean; const float yv = (vs - mean) / sqrtf(var + EPS) * p.conv_ln_g[chs] + p.conv_ln_b[chs];
        diag_max(p, 4, ldbf(MIX + (size_t)row * D + chs), yv * sigm(yv)); }
    if (stage == 5) { const int hh = h2 & 7, d4 = ((h2 >> 3) & 15) * 4; int t = row & 4095; if ((id & 3) == 1) t &= 255; if ((id & 3) == 2) t &= 63; const size_t rb = (size_t)b * SEQ;
        const bf16_t* q = QKV + (rb + t) * 1536 + hh * 64; float o0 = 0.f, o1 = 0.f, o2 = 0.f, o3 = 0.f, run = 0.f;
        for (int s = t - 1; s >= 0; --s) { const bf16_t* kk = QKV + (rb + s) * 1536 + 512 + hh * 64; float z = 0.f; for (int d = 0; d < 64; ++d) z += ldbf(q + d) * ldbf(kk + d);
            run += fmaxf(z, 0.f) + log2f(1.0f + exp2f(-fabsf(z))); const float a = exp2f(z - run); const bf16_t* vv = kk + 512 + d4;
            o0 += a * ldbf(vv); o1 += a * ldbf(vv + 1); o2 += a * ldbf(vv + 2); o3 += a * ldbf(vv + 3); if (run > 200.f) break; }
        const bf16_t* o = MIX + (rb + t) * D + CW + hh * 64 + d4;
        diag_max(p, 5, ldbf(o), o0); diag_max(p, 5, ldbf(o + 1), o1); diag_max(p, 5, ldbf(o + 2), o2); diag_max(p, 5, ldbf(o + 3), o3); }
    if (stage == 6) { const int col = h2 % D; const bf16_t* a = MIX + (size_t)row * D; const float yc = dotA(a, p.w_conv_out + col, D, CW), ya = dotA(a + CW, p.w_att_out + col, D, CW);
        diag_max(p, 6, ldbf(H + (size_t)row * D + col), ldbf(SGA + (size_t)row * D + col) * (ldbf(RATIO + (size_t)row * D + col) * yc + ya)); }
    if (stage == 7 || stage == 10) { const int col = h2 % D; const bool f = (stage == 10);
        const float ref = f ? dotA(HID + (size_t)row * DFF, p.w_ffn_out + col, D, DFF) : dotA(H + (size_t)row * D, p.w_o + col, D, D);
        diag_max(p, stage, ldbf(MIX + (size_t)row * D + col), ref);
        if ((id & 15) == 0) { float q = 0.f; for (int k = 0; k < D; ++k) { const float v = ldbf(MIX + (size_t)row * D + k); q += v * v; } float sq = 0.f; for (int k = 0; k < 16; ++k) sq += ssb[((size_t)(f ? M : 0) + row) * 16 + k]; diag_max(p, stage, sq, q); } }
    if (stage == 8 || stage == 11) { const bool f = (stage == 11); const int col = h2 % D; const float* xin = f ? p.out : p.x;
        float sq = 0.f; for (int k = 0; k < 16; ++k) sq += ssb[((size_t)(f ? M : 0) + row) * 16 + k];
        const float rs = 1.0f / sqrtf(sq / D + EPS);
        if (!f) { const float ref = xin[(size_t)row * D + col] + mod[b * 6144 + 2048 + col] * ldbf(MIX + (size_t)row * D + col) * rs * p.post_mix_g[col]; diag_max(p, 8, p.out[(size_t)row * D + col], ref); }
        float q = 0.f; for (int k = 0; k < D; ++k) { const float v = p.out[(size_t)row * D + k]; q += v * v; }
        const float r2 = 1.0f / sqrtf(q / D + EPS);
        const float ref = f ? p.out[(size_t)row * D + col] * r2 * p.pre_mix_g[D + col] * (1.0f + mod[(NB + b) * 6144 + 1024 + col]) + mod[(NB + b) * 6144 + col]
                            : p.out[(size_t)row * D + col] * r2 * p.pre_ffn_g[col] * (1.0f + mod[b * 6144 + 4096 + col]) + mod[b * 6144 + 3072 + col];
        diag_max(p, stage, ldbf(H + (size_t)row * D + col), ref); }
    if (stage == 9) { const int ch = h2 % DFF; const bf16_t* a = H + (size_t)row * D; const float g = dotA(a, p.w_ffn_in + ch, 2 * DFF, D), u = dotA(a, p.w_ffn_in + DFF + ch, 2 * DFF, D);
        diag_max(p, 9, ldbf(HID + (size_t)row * DFF + ch), g * sigm(g) * u); }
}
__global__ void chk_report(Params p) {
    const unsigned* dg = (const unsigned*)(p.ws + OFF_DIAG); int first = 0, second = 0;
    for (int s = 1; s <= 11; ++s) if (__uint_as_float(dg[s]) > 0.04f) { if (!first) first = s; else if (!second) second = s; }
    if (first) p.out[0] = 1000.0f * (10 * (first % 10) + (second % 10)) + (first >= 10 ? 500.f : 0.f);
}
#endif

#ifndef MK_PER_PHASE
#define MK_PER_PHASE 0
#endif
extern "C" void kernel_launch(void* const* d_in, const int* in_sizes, int n_in, void* d_out, int out_size, void* d_ws, size_t ws_size, hipStream_t stream) {
    static int grid = 0;
    if (grid == 0) {
        if (n_in != 18 || in_sizes[0] != M * D || out_size != M * D || ws_size < WS_END) { fprintf(stderr, "kernel_launch: unexpected shapes (n_in %d in0 %d out %d ws %zu need %zu)\n", n_in, in_sizes[0], out_size, ws_size, (size_t)WS_END); grid = -1; return; }
        int dev = 0, cus = 0, per_cu = 0;
        hipGetDevice(&dev); hipDeviceGetAttribute(&cus, hipDeviceAttributeMultiprocessorCount, dev);
        if (hipFuncSetAttribute((const void*)fwd_megakernel, hipFuncAttributeMaxDynamicSharedMemorySize, LDS_BYTES) != hipSuccess) { fprintf(stderr, "kernel_launch: hipFuncSetAttribute failed\n"); grid = -1; return; }
        if (hipOccupancyMaxActiveBlocksPerMultiprocessor(&per_cu, (const void*)fwd_megakernel, 512, LDS_BYTES) != hipSuccess || per_cu < 1) { fprintf(stderr, "kernel_launch: occupancy query failed (%d)\n", per_cu); (void)hipGetLastError(); per_cu = 1; }
        grid = cus * per_cu;
    }
    if (grid < 0) return;
    (void)hipMemsetAsync((unsigned char*)d_ws + OFF_DIAG, 0, ZERO_BYTES, stream);
    Params p{};
    const float** pp = (const float**)&p;
    for (int i = 0; i < 18; ++i) pp[i] = (const float*)d_in[i];
    p.out = (float*)d_out; p.ws = (unsigned char*)d_ws;
#if MK_PER_PHASE
    for (int ph = 0; ph < NPHASE; ++ph) { p.ph_lo = ph; p.ph_hi = ph + 1;
        hipLaunchKernelGGL(fwd_megakernel, dim3(grid), dim3(512), LDS_BYTES, stream, p);
#if MK_CHECK
        { Params q = p; q.ph_lo = 0; q.ph_hi = 0;
          auto CH = [&](int st) { hipLaunchKernelGGL(chk_kernel, dim3(8), dim3(64), 0, stream, q, st); };
          if (ph == 1) { CH(1); CH(2); } if (ph == 2) CH(3); if (ph == 3) { CH(4); CH(5); } if (ph == 4) CH(6); if (ph == 5) CH(7); if (ph == 6) CH(8);
          if (ph == 7) CH(9); if (ph == 8) CH(10); if (ph == 9) CH(11);
          if (ph == NPHASE - 1) hipLaunchKernelGGL(chk_report, dim3(1), dim3(1), 0, stream, q); }
#endif
    }
#else
    p.ph_lo = 0; p.ph_hi = NPHASE;
    void* args[] = {&p};
    hipError_t e = hipLaunchCooperativeKernel((const void*)fwd_megakernel, dim3(grid), dim3(512), args, LDS_BYTES, stream);
    if (e != hipSuccess) fprintf(stderr, "cooperative launch failed: %s (grid %d)\n", hipGetErrorString(e), grid);
#endif
}
```

```cpp
#include <hip/hip_runtime.h>
#include <hip/hip_cooperative_groups.h>
#include <cstdio>
#include <cstdint>
namespace cg = cooperative_groups;

#define DI __device__ __forceinline__
#define LAS __attribute__((address_space(3)))
typedef unsigned short bf16_t;
typedef short bf16x8 __attribute__((ext_vector_type(8)));
typedef short s16x4 __attribute__((ext_vector_type(4)));
typedef float f32x2 __attribute__((ext_vector_type(2)));
typedef float f32x4 __attribute__((ext_vector_type(4)));
typedef float f32x16 __attribute__((ext_vector_type(16)));
typedef unsigned u32x2 __attribute__((ext_vector_type(2)));
typedef unsigned u32x4 __attribute__((ext_vector_type(4)));
typedef __bf16 bf2_t __attribute__((ext_vector_type(2)));

constexpr int D = 1024, NB = 16, SEQ = 4096, M = NB * SEQ, DEPTH = 2;
constexpr int CW = 512, CK = 31, NH = 8, HD = 64, DFF = 2816, INC = 4608;
constexpr float EPS = 1e-6f;
constexpr float LOG2E = 1.4426950408889634f;
constexpr int LDS_BYTES = 135168 + 64;
constexpr int NPHASE = 2 + 8 * DEPTH;

constexpr size_t OFF_MOD = 0;
constexpr size_t OFF_DIAG = 786432;
constexpr size_t OFF_BAR = OFF_DIAG + 256;
constexpr size_t ZERO_BYTES = 256 + 3456 * 4;
constexpr size_t OFF_KN = 802816;
constexpr size_t OFF_WIN = 2097152;
constexpr size_t OFF_WMIX = OFF_WIN + 2ull * INC * D * 2;
constexpr size_t OFF_WO = OFF_WMIX + 2ull * D * D * 2;
constexpr size_t OFF_WF1 = OFF_WO + 2ull * D * D * 2;
constexpr size_t OFF_WF2 = OFF_WF1 + 2ull * 2 * DFF * D * 2;
constexpr size_t OFF_H = 67108864;
constexpr size_t OFF_MIX = OFF_H + (size_t)M * D * 2;
constexpr size_t OFF_R = OFF_MIX + (size_t)M * D * 2;
constexpr size_t OFF_U = OFF_R;
constexpr size_t OFF_QKV = OFF_U + (size_t)M * CW * 2;
constexpr size_t OFF_RATIO = OFF_QKV + (size_t)M * 1536 * 2;
constexpr size_t OFF_SGA = OFF_RATIO + (size_t)M * D * 2;
constexpr size_t OFF_HID = OFF_R;
constexpr size_t WS_END_ACT = OFF_SGA + (size_t)M * D * 2;
constexpr size_t OFF_SS = WS_END_ACT;
constexpr size_t OFF_XB = WS_END_ACT + 4ull * M * 16 * 4;
constexpr size_t WS_END = OFF_XB + (size_t)M * D * 2;
static_assert(OFF_WF2 + 2ull * D * DFF * 2 <= OFF_H, "weights overflow");
static_assert(OFF_HID + (size_t)M * DFF * 2 <= WS_END, "hid overflow");

struct Params {
    const float *x, *c, *ada_w, *ada_b, *pre_mix_g, *post_mix_g, *pre_ffn_g, *post_ffn_g, *w_in, *conv_w, *conv_b, *conv_ln_g, *conv_ln_b,
        *w_conv_out, *w_att_out, *w_o, *w_ffn_in, *w_ffn_out;
    float* out; unsigned char* ws; int ph_lo, ph_hi;
};

DI unsigned pk2(float a, float b) { f32x2 v = {a, b}; bf2_t r = __builtin_convertvector(v, bf2_t); return __builtin_bit_cast(unsigned, r); }
DI float bf_lo(unsigned w) { return __uint_as_float(w << 16); }
DI float bf_hi(unsigned w) { return __uint_as_float(w & 0xffff0000u); }
DI float fast_sigmoid(float x) { return __builtin_amdgcn_rcpf(1.0f + __builtin_amdgcn_exp2f(-x * LOG2E)); }
DI float wave_sum(float v) {
#pragma unroll
    for (int o = 1; o < 64; o <<= 1) v += __shfl_xor(v, o);
    return v;
}

namespace pg8 {
constexpr int BM = 256, BK = 64, HALF = 128, HTB = HALF * BK * 2, STAGE_BYTES = 8 * HTB, NXCD = 8, WGM = 4;
DI int lds_byte(int r, int c) { const int st = (r >> 4) * 2 + (c >> 5), rr = r & 15, cc = c & 31, ob = rr * 64 + cc * 2; return st * 1024 + (ob ^ (((ob >> 9) & 1) << 5)); }
DI void stage_rc(int b, int& R, int& C) { const int st = b / 1024, sb = b % 1024, swz = sb ^ (((sb >> 9) & 1) << 5); R = (st >> 1) * 16 + swz / 64; C = (st & 1) * 32 + (swz % 64) / 2; }
DI int perm32(int rho) { const int n = rho >> 4, i = rho & 15; return 8 * (i >> 2) + 4 * n + (i & 3); }
struct Unit { int pm, pn; };
struct Gemm { const bf16_t* A; const bf16_t* Bt; int M, N, K; };
struct StaticOrder {
    int nM, nN, nwg, G, c;
    DI void init(int M_, int N_, int G_, int c_) { nM = M_ / BM; nN = N_ / BM; nwg = nM * nN; G = G_; c = c_; }
    DI bool next(int i, Unit& u) const {
        const long L = (long)i * G + c; if (L >= nwg) return false;
        int wgid = (int)L; { const int q = nwg / NXCD, r = nwg % NXCD, xcd = wgid % NXCD, off = wgid / NXCD; wgid = (xcd < r ? xcd * (q + 1) : r * (q + 1) + (xcd - r) * q) + off; }
        const int nig = WGM * nN, gid = wgid / nig, fm = gid * WGM, gsz = (nM - fm) < WGM ? (nM - fm) : WGM;
        u.pm = fm + ((wgid % nig) % gsz); u.pn = (wgid % nig) / gsz; return true;
    }
};
#ifndef MK_ALIGN
#define MK_ALIGN true
#endif
#ifndef MK_SP2
#define MK_SP2 true
#endif
template <class Epi, bool ALIGN_EPI = MK_ALIGN, bool SP2 = MK_SP2>
DI void gemm_phase(LAS unsigned char* lds, const Gemm g, const StaticOrder& S, const Epi& E) {
    const int tid = threadIdx.x, wid = __builtin_amdgcn_readfirstlane(tid >> 6), lane = tid & 63, wr = wid >> 2, wc = wid & 3, fr = lane & 15, fq = lane >> 4;
    const int K = g.K, nt = K / BK;
    unsigned voffA[2];
#pragma unroll
    for (int i = 0; i < 2; ++i) { int R, C; stage_rc(tid * 16 + i * 8192, R, C); voffA[i] = (unsigned)(R * K + C) * 2u; }
    const size_t kstep = (size_t)(BK * 2);
    const size_t hstep = (size_t)HALF * K * 2;
    const size_t tstep = 2 * hstep;
    const unsigned ldsw = (unsigned)wid * 1024u;
    const int aoff = lds_byte(wr * 64 + fr, fq * 8), boff = lds_byte(wc * 32 + fr, fq * 8);
#define PG8_SA(b, h) (((b) * 2 + (h)) * HTB)
#define PG8_SB(b, h) ((4 + (b) * 2 + (h)) * HTB)
#define PG8_STAGE(bufoff, gbase) do { _Pragma("unroll") for (int _i = 0; _i < 2; ++_i) \
        __builtin_amdgcn_global_load_lds((const unsigned*)((const char*)(gbase) + voffA[_i]), (LAS unsigned*)(lds + (bufoff) + ldsw + _i * 8192), 16, 0, 0); } while (0)
#define PG8_LDA(dst, b, h) do { _Pragma("unroll") for (int m = 0; m < 4; ++m) _Pragma("unroll") for (int k = 0; k < 2; ++k) dst[m][k] = *(const LAS bf16x8*)(lds + PG8_SA(b, h) + aoff + m * 2048 + k * 1024); } while (0)
#define PG8_LDB(dst, b, h) do { _Pragma("unroll") for (int n = 0; n < 2; ++n) _Pragma("unroll") for (int k = 0; k < 2; ++k) dst[n][k] = *(const LAS bf16x8*)(lds + PG8_SB(b, h) + boff + n * 2048 + k * 1024); } while (0)
#define PG8_MMA(ai, bj, At, Bt) do { __builtin_amdgcn_s_setprio(1); _Pragma("unroll") for (int m = 0; m < 4; ++m) _Pragma("unroll") for (int n = 0; n < 2; ++n) _Pragma("unroll") for (int k = 0; k < 2; ++k) \
        acc[ai][bj][m][n] = __builtin_amdgcn_mfma_f32_16x16x32_bf16(Bt[n][k], At[m][k], acc[ai][bj][m][n], 0, 0, 0); __builtin_amdgcn_s_setprio(0); } while (0)
#define PG8_WAIT_V(n) asm volatile("s_waitcnt vmcnt(" #n ")" ::: "memory")
#define PG8_WAIT_L(n) asm volatile("s_waitcnt lgkmcnt(" #n ")" ::: "memory")
#define PG8_BAR __builtin_amdgcn_s_barrier()
#define PG8_SCHED __builtin_amdgcn_sched_barrier(0)
    Unit cur, nxt; int ui = 0;
    if (!S.next(0, cur)) return;
    f32x4 acc[2][2][4][2];
#pragma unroll
    for (int a = 0; a < 2; ++a)
#pragma unroll
        for (int b = 0; b < 2; ++b)
#pragma unroll
            for (int m = 0; m < 4; ++m)
#pragma unroll
                for (int n = 0; n < 2; ++n) acc[a][b][m][n] = (f32x4){0.f, 0.f, 0.f, 0.f};
    bf16x8 At[4][2], B0[2][2], B1[2][2];
    const char* cA = (const char*)g.A + (size_t)cur.pm * tstep; const char* cB = (const char*)g.Bt + (size_t)cur.pn * tstep;
    if constexpr (SP2) {
        PG8_STAGE(PG8_SB(0, 0), cB); PG8_STAGE(PG8_SB(0, 1), cB + hstep); PG8_STAGE(PG8_SA(0, 0), cA); PG8_STAGE(PG8_SA(0, 1), cA + hstep);
        if (wr == 1) PG8_BAR;
        PG8_WAIT_V(2); PG8_BAR;
        PG8_STAGE(PG8_SB(1, 0), cB + kstep); PG8_STAGE(PG8_SA(1, 0), cA + kstep); PG8_STAGE(PG8_SB(1, 1), cB + hstep + kstep);
        PG8_WAIT_V(6); PG8_BAR;
    } else {
        PG8_STAGE(PG8_SB(0, 0), cB); PG8_STAGE(PG8_SA(0, 0), cA); PG8_STAGE(PG8_SB(0, 1), cB + hstep); PG8_STAGE(PG8_SA(0, 1), cA + hstep);
        if (wr == 1) PG8_BAR;
        PG8_WAIT_V(4); PG8_BAR;
        PG8_STAGE(PG8_SB(1, 0), cB + kstep); PG8_STAGE(PG8_SA(1, 0), cA + kstep); PG8_STAGE(PG8_SB(1, 1), cB + hstep + kstep);
        PG8_WAIT_V(6); PG8_BAR;
    }
    for (;;) {
        const bool has_next = S.next(ui + 1, nxt);
        const char* nA = has_next ? (const char*)g.A + (size_t)nxt.pm * tstep : cA; const char* nB = has_next ? (const char*)g.Bt + (size_t)nxt.pn * tstep : cB;
        for (int t = 0; t < nt; t += 2) {
            if constexpr (Epi::MIDK) { if (t == (nt >> 1)) E.mid(acc, cur, wr, wc, fr, fq); }
            const bool last = (t == nt - 2);
            const char* a1 = cA + (size_t)(t + 1) * kstep;
            const char* a2 = last ? nA : cA + (size_t)(t + 2) * kstep; const char* b2 = last ? nB : cB + (size_t)(t + 2) * kstep;
            const char* a3 = a2 + kstep; const char* b3 = b2 + kstep;
            if constexpr (SP2) {
            PG8_LDB(B0, 0, 0); PG8_LDB(B1, 0, 1); PG8_SCHED; PG8_LDA(At, 0, 0); PG8_STAGE(PG8_SA(1, 1), a1 + hstep);
            PG8_WAIT_V(8); PG8_WAIT_L(0); PG8_BAR; PG8_MMA(0, 0, At, B0); PG8_MMA(0, 1, At, B1); PG8_BAR; PG8_SCHED;
            PG8_LDA(At, 0, 1); PG8_STAGE(PG8_SB(0, 0), b2); PG8_STAGE(PG8_SB(0, 1), b2 + hstep); PG8_STAGE(PG8_SA(0, 0), a2);
            PG8_WAIT_V(8); PG8_WAIT_L(0); PG8_BAR; PG8_MMA(1, 0, At, B0); PG8_MMA(1, 1, At, B1); PG8_BAR; PG8_SCHED;
            PG8_LDB(B0, 1, 0); PG8_LDB(B1, 1, 1); PG8_SCHED; PG8_LDA(At, 1, 0); PG8_STAGE(PG8_SA(0, 1), a2 + hstep);
            PG8_WAIT_V(8); PG8_WAIT_L(0); PG8_BAR; PG8_MMA(0, 0, At, B0); PG8_MMA(0, 1, At, B1); PG8_BAR; PG8_SCHED;
            PG8_LDA(At, 1, 1); PG8_STAGE(PG8_SB(1, 0), b3); PG8_STAGE(PG8_SB(1, 1), b3 + hstep); PG8_STAGE(PG8_SA(1, 0), a3);
            PG8_WAIT_V(8); PG8_WAIT_L(0); PG8_BAR; PG8_MMA(1, 0, At, B0); PG8_MMA(1, 1, At, B1); PG8_BAR; PG8_SCHED;
            } else {
            PG8_LDB(B0, 0, 0); PG8_SCHED; PG8_LDA(At, 0, 0); PG8_STAGE(PG8_SA(1, 1), a1 + hstep);
            PG8_WAIT_L(8); PG8_BAR; PG8_WAIT_L(0); PG8_MMA(0, 0, At, B0); PG8_BAR; PG8_SCHED;
            PG8_LDB(B1, 0, 1); PG8_STAGE(PG8_SB(0, 0), b2);
            PG8_BAR; PG8_WAIT_L(0); PG8_MMA(0, 1, At, B1); PG8_BAR;
            PG8_LDA(At, 0, 1); PG8_STAGE(PG8_SA(0, 0), a2);
            PG8_BAR; PG8_WAIT_L(0); PG8_MMA(1, 0, At, B0); PG8_BAR; PG8_SCHED;
            PG8_STAGE(PG8_SB(0, 1), b2 + hstep);
            PG8_WAIT_V(6); PG8_BAR; PG8_MMA(1, 1, At, B1); PG8_BAR;
            PG8_LDB(B0, 1, 0); PG8_SCHED; PG8_LDA(At, 1, 0); PG8_STAGE(PG8_SA(0, 1), a2 + hstep);
            PG8_WAIT_L(8); PG8_BAR; PG8_WAIT_L(0); PG8_MMA(0, 0, At, B0); PG8_BAR; PG8_SCHED;
            PG8_LDB(B1, 1, 1); PG8_STAGE(PG8_SB(1, 0), b3);
            PG8_BAR; PG8_WAIT_L(0); PG8_MMA(0, 1, At, B1); PG8_BAR;
            PG8_LDA(At, 1, 1); PG8_STAGE(PG8_SA(1, 0), a3);
            PG8_BAR; PG8_WAIT_L(0); PG8_MMA(1, 0, At, B0); PG8_BAR; PG8_SCHED;
            PG8_STAGE(PG8_SB(1, 1), b3 + hstep);
            PG8_WAIT_V(6); PG8_BAR; PG8_MMA(1, 1, At, B1); PG8_BAR;
            }
        }
        if constexpr (ALIGN_EPI) { if (wr == 0) PG8_BAR; }
        E(acc, cur, wr, wc, fr, fq);
        if (!has_next) break;
#pragma unroll
        for (int a = 0; a < 2; ++a)
#pragma unroll
            for (int b = 0; b < 2; ++b)
#pragma unroll
                for (int m = 0; m < 4; ++m)
#pragma unroll
                    for (int n = 0; n < 2; ++n) acc[a][b][m][n] = (f32x4){0.f, 0.f, 0.f, 0.f};
        cur = nxt; cA = nA; cB = nB; ++ui;
        if constexpr (ALIGN_EPI) { if (wr == 1) PG8_BAR; }
    }
    PG8_WAIT_V(0);
    if constexpr (!ALIGN_EPI) { if (wr == 0) PG8_BAR; }
    PG8_BAR;
#undef PG8_SA
#undef PG8_SB
#undef PG8_STAGE
#undef PG8_LDA
#undef PG8_LDB
#undef PG8_MMA
#undef PG8_WAIT_V
#undef PG8_WAIT_L
#undef PG8_BAR
#undef PG8_SCHED
}
}
using pg8::Unit;
typedef f32x4 AccT[2][2][4][2];

struct EpiIn {
    static constexpr bool MIDK = false;
    bf16_t *U, *QKV, *RATIO, *SGA; float* KN;
    DI void mid(AccT&, const Unit&, int, int, int, int) const {}
    DI void operator()(const AccT& acc, const Unit& u, int wr, int wc, int fr, int fq) const {
        const int row0 = u.pm * 256 + wr * 64 + fr;
        if (u.pn < 4) {
#pragma unroll
            for (int ai = 0; ai < 2; ++ai)
#pragma unroll
                for (int m = 0; m < 4; ++m) { const size_t row = (size_t)(row0 + ai * 128 + m * 16); const int ch0 = u.pn * 128 + wc * 32 + fq * 8; float o[8];
#pragma unroll
                    for (int n = 0; n < 2; ++n) { const f32x4 a = acc[ai][0][m][n], gt = acc[ai][1][m][n];
#pragma unroll
                        for (int j = 0; j < 4; ++j) o[4 * n + j] = a[j] * fast_sigmoid(gt[j]); }
                    u32x4 w; w.x = pk2(o[0], o[1]); w.y = pk2(o[2], o[3]); w.z = pk2(o[4], o[5]); w.w = pk2(o[6], o[7]);
                    *(u32x4*)(U + row * CW + ch0) = w; }
        } else if (u.pn < 10) {
            const float sc = (u.pn < 6) ? (0.125f * LOG2E) : 1.0f;
#pragma unroll
            for (int ai = 0; ai < 2; ++ai)
#pragma unroll
                for (int m = 0; m < 4; ++m) { const size_t row = (size_t)(row0 + ai * 128 + m * 16);
#pragma unroll
                    for (int bj = 0; bj < 2; ++bj) { const int col0 = (u.pn - 4) * 256 + bj * 128 + wc * 32 + fq * 8;
                        const f32x4 v0 = acc[ai][bj][m][0] * sc, v1 = acc[ai][bj][m][1] * sc;
                        u32x4 w; w.x = pk2(v0[0], v0[1]); w.y = pk2(v0[2], v0[3]); w.z = pk2(v1[0], v1[1]); w.w = pk2(v1[2], v1[3]);
                        *(u32x4*)(QKV + row * 1536 + col0) = w; } }
            if (u.pn == 6 || u.pn == 7) {
#pragma unroll
                for (int ai = 0; ai < 2; ++ai)
#pragma unroll
                    for (int bj = 0; bj < 2; ++bj) { float mx = 0.f;
#pragma unroll
                        for (int m = 0; m < 4; ++m) { const f32x4 v0 = acc[ai][bj][m][0], v1 = acc[ai][bj][m][1]; float q = 0.f;
#pragma unroll
                            for (int j = 0; j < 4; ++j) { const float a = bf_lo(pk2(v0[j], 0.f)), c = bf_lo(pk2(v1[j], 0.f)); q += a * a + c * c; }
                            q += __shfl_xor(q, 16); q += __shfl_xor(q, 32); mx = fmaxf(mx, q); }
#pragma unroll
                        for (int o = 1; o < 16; o <<= 1) mx = fmaxf(mx, __shfl_xor(mx, o));
                        const int rowb = u.pm * 256 + ai * 128 + wr * 64, hh = (u.pn - 6) * 4 + bj * 2 + (wc >> 1);
                        if ((fr | fq) == 0) KN[((size_t)(((rowb >> 12) * 8 + hh) * 64 + ((rowb & 4095) >> 6))) * 2 + (wc & 1)] = mx; }
            }
        } else {
#pragma unroll
            for (int ai = 0; ai < 2; ++ai)
#pragma unroll
                for (int m = 0; m < 4; ++m) { const size_t row = (size_t)(row0 + ai * 128 + m * 16); const int ch0 = (u.pn - 10) * 128 + wc * 32 + fq * 8; float r[8], s[8];
#pragma unroll
                    for (int n = 0; n < 2; ++n) { const f32x4 gc = acc[ai][0][m][n], ga = acc[ai][1][m][n];
#pragma unroll
                        for (int j = 0; j < 4; ++j) { const float ea = 1.0f + __builtin_amdgcn_exp2f(-fmaxf(ga[j], -80.f) * LOG2E);
                            s[4 * n + j] = __builtin_amdgcn_rcpf(ea); r[4 * n + j] = fast_sigmoid(gc[j]) * ea; } }
                    u32x4 wr_, ws_; wr_.x = pk2(r[0], r[1]); wr_.y = pk2(r[2], r[3]); wr_.z = pk2(r[4], r[5]); wr_.w = pk2(r[6], r[7]);
                    ws_.x = pk2(s[0], s[1]); ws_.y = pk2(s[2], s[3]); ws_.z = pk2(s[4], s[5]); ws_.w = pk2(s[6], s[7]);
                    *(u32x4*)(RATIO + row * D + ch0) = wr_; *(u32x4*)(SGA + row * D + ch0) = ws_; }
        }
    }
};
struct EpiMix {
    static constexpr bool MIDK = true;
    const bf16_t *RATIO, *SGA; bf16_t* O;
    DI void scale(AccT& acc, const bf16_t* T, const Unit& u, int wr, int wc, int fr, int fq) const {
        int row0 = u.pm * 256 + wr * 64 + fr; asm volatile("" : "+v"(row0));
        const bf16_t* Tp = T + (size_t)row0 * D + u.pn * 256 + wc * 32 + fq * 8;
#pragma unroll
        for (int ai = 0; ai < 2; ++ai)
#pragma unroll
            for (int m = 0; m < 4; ++m) {
#pragma unroll
                for (int bj = 0; bj < 2; ++bj) {
                    const u32x4 w = *(const u32x4*)(Tp + (ai * 128 + m * 16) * D + bj * 128);
                    acc[ai][bj][m][0] *= (f32x4){bf_lo(w.x), bf_hi(w.x), bf_lo(w.y), bf_hi(w.y)};
                    acc[ai][bj][m][1] *= (f32x4){bf_lo(w.z), bf_hi(w.z), bf_lo(w.w), bf_hi(w.w)}; } }
    }
    DI void mid(AccT& acc, const Unit& u, int wr, int wc, int fr, int fq) const { scale(acc, RATIO, u, wr, wc, fr, fq); }
    DI void operator()(AccT& acc, const Unit& u, int wr, int wc, int fr, int fq) const {
        scale(acc, SGA, u, wr, wc, fr, fq);
        const int row0 = u.pm * 256 + wr * 64 + fr;
#pragma unroll
        for (int ai = 0; ai < 2; ++ai)
#pragma unroll
            for (int m = 0; m < 4; ++m) { const size_t row = (size_t)(row0 + ai * 128 + m * 16);
#pragma unroll
                for (int bj = 0; bj < 2; ++bj) { const int col0 = u.pn * 256 + bj * 128 + wc * 32 + fq * 8;
                    const f32x4 v0 = acc[ai][bj][m][0], v1 = acc[ai][bj][m][1];
                    u32x4 w; w.x = pk2(v0[0], v0[1]); w.y = pk2(v0[2], v0[3]); w.z = pk2(v1[0], v1[1]); w.w = pk2(v1[2], v1[3]);
                    *(u32x4*)(O + row * D + col0) = w; } }
    }
};
struct EpiY {
    static constexpr bool MIDK = false;
    bf16_t* Y; float* ss;
    DI void mid(AccT&, const Unit&, int, int, int, int) const {}
    DI void operator()(const AccT& acc, const Unit& u, int wr, int wc, int fr, int fq) const {
        const int row0 = u.pm * 256 + wr * 64 + fr;
#pragma unroll
        for (int ai = 0; ai < 2; ++ai)
#pragma unroll
            for (int m = 0; m < 4; ++m) { const size_t row = (size_t)(row0 + ai * 128 + m * 16); float q = 0.f;
#pragma unroll
                for (int bj = 0; bj < 2; ++bj) { const int col0 = u.pn * 256 + bj * 128 + wc * 32 + fq * 8;
                    const f32x4 v0 = acc[ai][bj][m][0], v1 = acc[ai][bj][m][1];
                    q += (v0[0] * v0[0] + v0[1] * v0[1]) + (v0[2] * v0[2] + v0[3] * v0[3]) + (v1[0] * v1[0] + v1[1] * v1[1]) + (v1[2] * v1[2] + v1[3] * v1[3]);
                    u32x4 w; w.x = pk2(v0[0], v0[1]); w.y = pk2(v0[2], v0[3]); w.z = pk2(v1[0], v1[1]); w.w = pk2(v1[2], v1[3]);
                    *(u32x4*)(Y + row * D + col0) = w; }
                q += __shfl_xor(q, 16); q += __shfl_xor(q, 32);
                if (fq == 0) ss[row * 16 + u.pn * 4 + wc] = q; }
    }
};
struct EpiF1 {
    static constexpr bool MIDK = false;
    bf16_t* HID;
    DI void mid(AccT&, const Unit&, int, int, int, int) const {}
    DI void operator()(const AccT& acc, const Unit& u, int wr, int wc, int fr, int fq) const {
        const int row0 = u.pm * 256 + wr * 64 + fr;
#pragma unroll
        for (int ai = 0; ai < 2; ++ai)
#pragma unroll
            for (int m = 0; m < 4; ++m) { const size_t row = (size_t)(row0 + ai * 128 + m * 16); const int ch0 = u.pn * 128 + wc * 32 + fq * 8; float o[8];
#pragma unroll
                for (int n = 0; n < 2; ++n) { const f32x4 gt = acc[ai][0][m][n], up = acc[ai][1][m][n];
#pragma unroll
                    for (int j = 0; j < 4; ++j) o[4 * n + j] = gt[j] * fast_sigmoid(gt[j]) * up[j]; }
                u32x4 w; w.x = pk2(o[0], o[1]); w.y = pk2(o[2], o[3]); w.z = pk2(o[4], o[5]); w.w = pk2(o[6], o[7]);
                *(u32x4*)(HID + row * DFF + ch0) = w; }
    }
};

DI int src_pair(int np, int second_off) { const int pn = np >> 8, tc = np & 255, bj = tc >> 7, wc = (tc >> 5) & 3; return pn * 128 + wc * 32 + pg8::perm32(tc & 31) + bj * second_off; }
DI int src_nat(int np) { return (np & ~31) + pg8::perm32(np & 31); }
DI void tr_item(const float* W, int ldw, bf16_t* WT, int Kd, int kdst0, int ksrc0, int n0, int srccol, LAS float* scr, int lane) {
    const float* src = W + (size_t)ksrc0 * ldw + srccol;
#pragma unroll 8
    for (int i = 0; i < 32; ++i) { const int kk = 2 * i + (lane >> 5); scr[kk * 33 + (lane & 31)] = src[(size_t)kk * ldw]; }
    asm volatile("s_waitcnt lgkmcnt(0)" ::: "memory");
    const int c = lane & 7;
#pragma unroll
    for (int j = 0; j < 4; ++j) { const int n = (lane >> 3) + 8 * j; const LAS float* s = scr + (8 * c) * 33 + n;
        u32x4 o; o.x = pk2(s[0 * 33], s[1 * 33]); o.y = pk2(s[2 * 33], s[3 * 33]); o.z = pk2(s[4 * 33], s[5 * 33]); o.w = pk2(s[6 * 33], s[7 * 33]);
        *(u32x4*)(WT + (size_t)(n0 + n) * Kd + kdst0 + 8 * c) = o; }
    asm volatile("s_waitcnt lgkmcnt(0)" ::: "memory");
}
constexpr int TR_IN = 16 * 144, TR_MIX = 16 * 32, TR_O = 16 * 32, TR_F1 = 16 * 176, TR_F2 = 44 * 32, TR_LAYER = TR_IN + TR_MIX + TR_O + TR_F1 + TR_F2;
constexpr int MOD_ITEMS = 2 * 96 * 4;
DI void phase0(const Params& p, LAS unsigned char* lds) {
    const int lane = threadIdx.x & 63, wave = threadIdx.x >> 6;
    LAS float* scr = (LAS float*)(lds + wave * 16384);
    const int gw = blockIdx.x * 8 + wave, NGW = gridDim.x * 8;
    for (int q = blockIdx.x; q < 192; q += gridDim.x) {
        const int kc = wave, l = q / 96, col = (q % 96) * 64 + lane;
        const float* W = p.ada_w + (size_t)l * D * 6144 + col;
        float acc[16];
#pragma unroll
        for (int b = 0; b < 16; ++b) acc[b] = 0.f;
        for (int k0 = kc * 128; k0 < kc * 128 + 128; k0 += 16) {
            float w[16], sv[4];
#pragma unroll
            for (int kq = 0; kq < 16; ++kq) w[kq] = W[(size_t)(k0 + kq) * 6144];
#pragma unroll
            for (int g = 0; g < 4; ++g) { const float cv = p.c[(lane & 15) * D + k0 + 4 * g + (lane >> 4)]; sv[g] = cv * fast_sigmoid(cv); }
#pragma unroll
            for (int kq = 0; kq < 16; ++kq)
#pragma unroll
                for (int b = 0; b < 16; ++b) acc[b] += __uint_as_float(__builtin_amdgcn_readlane(__float_as_uint(sv[kq >> 2]), b + 16 * (kq & 3))) * w[kq];
        }
        LAS float* part = (LAS float*)lds;
#pragma unroll
        for (int b = 0; b < 16; ++b) part[(wave * 16 + b) * 64 + lane] = acc[b];
        __syncthreads();
        if (wave < 2) { float* mo = (float*)(p.ws + OFF_MOD) + (size_t)l * NB * 6144 + col; const float bias = p.ada_b[l * 6144 + col];
#pragma unroll
            for (int bb = 0; bb < 8; ++bb) { const int b = wave * 8 + bb; float t = 0.f;
#pragma unroll
                for (int w8 = 0; w8 < 8; ++w8) t += part[(w8 * 16 + b) * 64 + lane];
                mo[b * 6144] = t + bias; } }
        __syncthreads();
    }
    for (int it = gw + MOD_ITEMS; it < MOD_ITEMS + 2 * TR_LAYER; it += NGW) {
        {
            int r = it - MOD_ITEMS; const int l = r / TR_LAYER; r -= l * TR_LAYER;
            if (r < TR_IN) { const int kb = r / 144, nb = r % 144, n0 = nb * 32, np = n0 + (lane & 31);
                const int sc = np < 1024 ? src_pair(np, 512) : (np < 2560 ? src_nat(np) : 2560 + src_pair(np - 2560, 1024));
                tr_item(p.w_in + (size_t)l * D * INC, INC, (bf16_t*)(p.ws + OFF_WIN) + (size_t)l * INC * D, D, kb * 64, kb * 64, n0, sc, scr, lane); continue; }
            r -= TR_IN;
            if (r < TR_MIX) { const int kb = r / 32, nb = r % 32, n0 = nb * 32, sc = src_nat(n0 + (lane & 31));
                const float* W = kb < 8 ? p.w_conv_out + (size_t)l * CW * D : p.w_att_out + (size_t)l * CW * D;
                tr_item(W, D, (bf16_t*)(p.ws + OFF_WMIX) + (size_t)l * D * D, D, kb * 64, (kb & 7) * 64, n0, sc, scr, lane); continue; }
            r -= TR_MIX;
            if (r < TR_O) { const int kb = r / 32, nb = r % 32, n0 = nb * 32, sc = src_nat(n0 + (lane & 31));
                tr_item(p.w_o + (size_t)l * D * D, D, (bf16_t*)(p.ws + OFF_WO) + (size_t)l * D * D, D, kb * 64, kb * 64, n0, sc, scr, lane); continue; }
            r -= TR_O;
            if (r < TR_F1) { const int kb = r / 176, nb = r % 176, n0 = nb * 32, sc = src_pair(n0 + (lane & 31), DFF);
                tr_item(p.w_ffn_in + (size_t)l * D * 2 * DFF, 2 * DFF, (bf16_t*)(p.ws + OFF_WF1) + (size_t)l * 2 * DFF * D, D, kb * 64, kb * 64, n0, sc, scr, lane); continue; }
            r -= TR_F1;
            { const int kb = r / 32, nb = r % 32, n0 = nb * 32, sc = src_nat(n0 + (lane & 31));
                tr_item(p.w_ffn_out + (size_t)l * DFF * D, D, (bf16_t*)(p.ws + OFF_WF2) + (size_t)l * D * DFF, DFF, kb * 64, kb * 64, n0, sc, scr, lane); }
        }
    }
}

DI void rowpass(const float* xin, const bf16_t* xinb, const bf16_t* y, const float* ss, const float* gate, const float* postg, float* xout, bf16_t* xoutb,
                const float* gnext, const float* scn, const float* shn, bf16_t* hout) {
    const int lane = threadIdx.x & 63, wave = threadIdx.x >> 6;
    const int gw = blockIdx.x * 8 + wave, NGW = gridDim.x * 8;
    constexpr int NR = 4, RPW = 32;
    for (int base = gw * RPW; base < M; base += NGW * RPW) {
        const int b = base >> 12;
        f32x4 c1[4], c2[4], c3[4];
#pragma unroll
        for (int j = 0; j < 4; ++j) { const int col = 4 * lane + 256 * j;
            c1[j] = y ? *(const f32x4*)(gate + b * 6144 + col) * *(const f32x4*)(postg + col) : (f32x4){0.f, 0.f, 0.f, 0.f};
            if (gnext) { c2[j] = *(const f32x4*)(gnext + col) * (1.0f + *(const f32x4*)(scn + b * 6144 + col)); c3[j] = *(const f32x4*)(shn + b * 6144 + col); }
            else { c2[j] = (f32x4){0.f, 0.f, 0.f, 0.f}; c3[j] = c2[j]; } }
        for (int r0 = 0; r0 < RPW; r0 += NR) {
            f32x4 v[NR][4]; u32x2 yw[NR][4]; float sq[NR];
#pragma unroll
            for (int q = 0; q < NR; ++q) { const size_t row = (size_t)(base + r0 + q);
#pragma unroll
                for (int j = 0; j < 4; ++j) {
                    if (xinb) { const u32x2 w = *(const u32x2*)(xinb + row * D + 4 * lane + 256 * j); v[q][j] = (f32x4){bf_lo(w.x), bf_hi(w.x), bf_lo(w.y), bf_hi(w.y)}; }
                    else v[q][j] = *(const f32x4*)(xin + row * D + 4 * lane + 256 * j); }
                if (y) { sq[q] = lane < 16 ? ss[row * 16 + lane] : 0.f;
#pragma unroll
                    for (int j = 0; j < 4; ++j) yw[q][j] = *(const u32x2*)(y + row * D + 4 * lane + 256 * j); } }
#pragma unroll
            for (int q = 0; q < NR; ++q) { const size_t row = (size_t)(base + r0 + q);
                if (y) {
                    const float rs = __builtin_amdgcn_rsqf(wave_sum(sq[q]) * (1.0f / D) + EPS);
#pragma unroll
                    for (int j = 0; j < 4; ++j) { const int col = 4 * lane + 256 * j; const u32x2 w = yw[q][j];
                        const f32x4 yv = {bf_lo(w.x), bf_hi(w.x), bf_lo(w.y), bf_hi(w.y)};
                        v[q][j] += (yv * rs) * c1[j];
                        if (xoutb) { u32x2 wo; wo.x = pk2(v[q][j].x, v[q][j].y); wo.y = pk2(v[q][j].z, v[q][j].w); *(u32x2*)(xoutb + row * D + col) = wo; }
                        else *(f32x4*)(xout + row * D + col) = v[q][j]; }
                }
                if (gnext) {
                    float s = 0.f;
#pragma unroll
                    for (int j = 0; j < 4; ++j) s += (v[q][j].x * v[q][j].x + v[q][j].y * v[q][j].y) + (v[q][j].z * v[q][j].z + v[q][j].w * v[q][j].w);
                    const float r = __builtin_amdgcn_rsqf(wave_sum(s) * (1.0f / D) + EPS);
#pragma unroll
                    for (int j = 0; j < 4; ++j) { const int col = 4 * lane + 256 * j;
                        const f32x4 hv = (v[q][j] * r) * c2[j] + c3[j];
                        u32x2 w; w.x = pk2(hv.x, hv.y); w.y = pk2(hv.z, hv.w);
                        *(u32x2*)(hout + row * D + col) = w; }
                }
            }
        }
    }
}

DI int crow(int r, int hi) { return (r & 3) + 8 * (r >> 2) + 4 * hi; }
#define MFMA32(a, b, c) __builtin_amdgcn_mfma_f32_32x32x16_bf16((a), (b), (c), 0, 0, 0)
typedef short v4i16_t __attribute__((ext_vector_type(4)));
DI s16x4 vtr(const LAS unsigned char* p) { return __builtin_bit_cast(s16x4, __builtin_amdgcn_ds_read_tr16_b64_v4i16((LAS v4i16_t*)p)); }
DI float softplus2(float z) {
    return fmaxf(z, 0.f) + __builtin_amdgcn_logf(1.0f + __builtin_amdgcn_exp2f(-fabsf(z)));
}
constexpr int KPITCH = 144, KVBUF = 64 * KPITCH;
DI void attn_wave(const bf16_t* QKV, const float* knp, bf16_t* OUT, LAS unsigned char* vl, int bh, int qb) {
    const int lane = threadIdx.x & 63, r32 = lane & 31, hi = lane >> 5;
    const int b = bh >> 3, h = bh & 7; const size_t rowbase = (size_t)b * SEQ;
    const int wq0 = qb * 32, tq = wq0 + r32;
    bf16x8 qf[4];
    { const bf16_t* qp = QKV + (rowbase + tq) * 1536 + h * 64 + hi * 8;
#pragma unroll
      for (int d0 = 0; d0 < 4; ++d0) qf[d0] = *(const bf16x8*)(qp + d0 * 16); }
    float qn;
    { float s = 0.f;
#pragma unroll
      for (int d0 = 0; d0 < 4; ++d0) { const u32x4 w = __builtin_bit_cast(u32x4, qf[d0]);
          s += bf_lo(w.x) * bf_lo(w.x) + bf_hi(w.x) * bf_hi(w.x) + bf_lo(w.y) * bf_lo(w.y) + bf_hi(w.y) * bf_hi(w.y) + bf_lo(w.z) * bf_lo(w.z) + bf_hi(w.z) * bf_hi(w.z) + bf_lo(w.w) * bf_lo(w.w) + bf_hi(w.w) * bf_hi(w.w); }
      auto rr = __builtin_amdgcn_permlane32_swap(__float_as_uint(s), __float_as_uint(s), false, false);
      qn = sqrtf(__uint_as_float(rr[0]) + __uint_as_float(rr[1])) * 1.001f; }
    float knpref;
    { const f32x2 kp = *(const f32x2*)(knp + ((size_t)bh * 64 + lane) * 2); float v = sqrtf(kp.x + kp.y) * 1.001f;
#pragma unroll
      for (int o = 1; o < 64; o <<= 1) { const float t = __shfl_up(v, o); if (lane >= o) v = fmaxf(v, t); }
      knpref = v; }
    f32x16 o0, o1;
#pragma unroll
    for (int i = 0; i < 16; ++i) { o0[i] = 0.f; o1[i] = 0.f; }
    float R = 0.f;
    int kb = (wq0 + 31) >> 6;
    const bf16_t* kbase = QKV + rowbase * 1536 + 512 + h * 64;
    bf16x8 ka[4], kc[4];
    { const bf16_t* kp = kbase + (size_t)(kb * 64 + r32) * 1536 + hi * 8;
#pragma unroll
      for (int d0 = 0; d0 < 4; ++d0) { ka[d0] = *(const bf16x8*)(kp + d0 * 16); kc[d0] = *(const bf16x8*)(kp + 32 * 1536 + d0 * 16); } }
    const int vq = (lane & 15) >> 2, vp = lane & 3, vblk = (lane >> 4) & 1;
    const unsigned vlane = (4 * hi + vq) * KPITCH + vblk * 32 + vp * 8;
    const unsigned vst = (lane >> 3) * KPITCH + (lane & 7) * 16;
    const float lomask = hi ? 0.f : 1.f;
    for (;;) {
        const int s0 = kb * 64;
        u32x4 vr[8];
        { const bf16_t* vp_ = kbase + 512 + (size_t)(s0 + (lane >> 3)) * 1536 + (lane & 7) * 8;
#pragma unroll
          for (int i = 0; i < 8; ++i) vr[i] = *(const u32x4*)(vp_ + (size_t)(8 * i) * 1536); }
        f32x16 z0, z1;
#pragma unroll
        for (int i = 0; i < 16; ++i) { z0[i] = 0.f; z1[i] = 0.f; }
#pragma unroll
        for (int d0 = 0; d0 < 4; ++d0) { z0 = MFMA32(ka[d0], qf[d0], z0); z1 = MFMA32(kc[d0], qf[d0], z1); }
        if (kb > 0) { const bf16_t* kp = kbase + (size_t)((kb - 1) * 64 + r32) * 1536 + hi * 8;
#pragma unroll
            for (int d0 = 0; d0 < 4; ++d0) { ka[d0] = *(const bf16x8*)(kp + d0 * 16); kc[d0] = *(const bf16x8*)(kp + 32 * 1536 + d0 * 16); } }
        if (s0 + 63 >= wq0) {
#pragma unroll
            for (int i = 0; i < 16; ++i) { const int kv = s0 + crow(i, hi); if (kv >= tq) z0[i] = -INFINITY; if (kv + 32 >= tq) z1[i] = -INFINITY; }
        }
        f32x16 c0, c1; float Glo[8], Ghi[8];
#pragma unroll
        for (int g = 0; g < 4; ++g) {
            float a3 = softplus2(z0[4 * g + 3]), a2 = softplus2(z0[4 * g + 2]) + a3, a1 = softplus2(z0[4 * g + 1]) + a2, a0 = softplus2(z0[4 * g]) + a1;
            c0[4 * g + 3] = a3; c0[4 * g + 2] = a2; c0[4 * g + 1] = a1; c0[4 * g] = a0;
            auto rr = __builtin_amdgcn_permlane32_swap(__float_as_uint(a0), __float_as_uint(a0), false, false);
            Glo[g] = __uint_as_float(rr[0]); Ghi[g] = __uint_as_float(rr[1]);
            float b3 = softplus2(z1[4 * g + 3]), b2 = softplus2(z1[4 * g + 2]) + b3, b1 = softplus2(z1[4 * g + 1]) + b2, b0 = softplus2(z1[4 * g]) + b1;
            c1[4 * g + 3] = b3; c1[4 * g + 2] = b2; c1[4 * g + 1] = b1; c1[4 * g] = b0;
            auto ss_ = __builtin_amdgcn_permlane32_swap(__float_as_uint(b0), __float_as_uint(b0), false, false);
            Glo[4 + g] = __uint_as_float(ss_[0]); Ghi[4 + g] = __uint_as_float(ss_[1]);
        }
        float run = R;
        u32x4 pf[2][2];
#pragma unroll
        for (int c = 7; c >= 0; --c) {
            const float base = __builtin_fmaf(Ghi[c], lomask, run);
            const int g = c & 3;
            float a[4];
            if (c >= 4) {
#pragma unroll
                for (int j = 0; j < 4; ++j) a[j] = __builtin_amdgcn_exp2f(z1[4 * g + j] - (c1[4 * g + j] + base));
                if (g & 1) { pf[1][g >> 1].z = pk2(a[0], a[1]); pf[1][g >> 1].w = pk2(a[2], a[3]); } else { pf[1][g >> 1].x = pk2(a[0], a[1]); pf[1][g >> 1].y = pk2(a[2], a[3]); }
            } else {
#pragma unroll
                for (int j = 0; j < 4; ++j) a[j] = __builtin_amdgcn_exp2f(z0[4 * g + j] - (c0[4 * g + j] + base));
                if (g & 1) { pf[0][g >> 1].z = pk2(a[0], a[1]); pf[0][g >> 1].w = pk2(a[2], a[3]); } else { pf[0][g >> 1].x = pk2(a[0], a[1]); pf[0][g >> 1].y = pk2(a[2], a[3]); }
            }
            run += Glo[c] + Ghi[c];
        }
        R = run;
#pragma unroll
        for (int i = 0; i < 8; ++i) *(LAS u32x4*)(vl + vst + i * 8 * KPITCH) = vr[i];
#pragma unroll
        for (int kt = 0; kt < 2; ++kt)
#pragma unroll
            for (int s = 0; s < 2; ++s) {
                const LAS unsigned char* vb = vl + vlane + (32 * kt + 16 * s) * KPITCH;
                const s16x4 l0 = vtr(vb), h0 = vtr(vb + 8 * KPITCH), l1 = vtr(vb + 64), h1 = vtr(vb + 64 + 8 * KPITCH);
                const bf16x8 v0 = __builtin_shufflevector(l0, h0, 0, 1, 2, 3, 4, 5, 6, 7), v1 = __builtin_shufflevector(l1, h1, 0, 1, 2, 3, 4, 5, 6, 7);
                const bf16x8 pb = __builtin_bit_cast(bf16x8, pf[kt][s]);
                o0 = MFMA32(v0, pb, o0); o1 = MFMA32(v1, pb, o1);
            }
        if (kb == 0) break;
        const float kbound = __uint_as_float(__builtin_amdgcn_readlane(__float_as_uint(knpref), kb - 1));
        if (__all((R - qn * kbound) > 160.f)) break;
        --kb;
    }
    bf16_t* op = OUT + (rowbase + tq) * D + CW + h * 64 + 4 * hi;
#pragma unroll
    for (int g = 0; g < 4; ++g) {
        u32x2 w0, w1; w0.x = pk2(o0[4 * g], o0[4 * g + 1]); w0.y = pk2(o0[4 * g + 2], o0[4 * g + 3]); w1.x = pk2(o1[4 * g], o1[4 * g + 1]); w1.y = pk2(o1[4 * g + 2], o1[4 * g + 3]);
        *(u32x2*)(op + 8 * g) = w0; *(u32x2*)(op + 32 + 8 * g) = w1;
    }
}

constexpr int ATT_BUF = 4 * KVBUF;
DI void attn_block(const bf16_t* QKV, const float* knp, bf16_t* OUT, LAS unsigned char* lds, int b, int hp, int qt) {
    const int tid = threadIdx.x, lane = tid & 63, r32 = lane & 31, hi = lane >> 5; const int wid = __builtin_amdgcn_readfirstlane(tid >> 6);
    const int hsel = wid >> 2, h = 2 * hp + hsel, bh = b * 8 + h; const size_t rowbase = (size_t)b * SEQ;
    const int q0 = qt * 128, wq0 = q0 + (wid & 3) * 32, tq = wq0 + r32;
    bf16x8 qf[4];
    { const bf16_t* qp = QKV + (rowbase + tq) * 1536 + h * 64 + hi * 8;
#pragma unroll
      for (int d0 = 0; d0 < 4; ++d0) qf[d0] = *(const bf16x8*)(qp + d0 * 16); }
    float qn;
    { float s = 0.f;
#pragma unroll
      for (int d0 = 0; d0 < 4; ++d0) { const u32x4 w = __builtin_bit_cast(u32x4, qf[d0]);
          s += bf_lo(w.x) * bf_lo(w.x) + bf_hi(w.x) * bf_hi(w.x) + bf_lo(w.y) * bf_lo(w.y) + bf_hi(w.y) * bf_hi(w.y) + bf_lo(w.z) * bf_lo(w.z) + bf_hi(w.z) * bf_hi(w.z) + bf_lo(w.w) * bf_lo(w.w) + bf_hi(w.w) * bf_hi(w.w); }
      auto rr = __builtin_amdgcn_permlane32_swap(__float_as_uint(s), __float_as_uint(s), false, false);
      qn = sqrtf(__uint_as_float(rr[0]) + __uint_as_float(rr[1])) * 1.001f; }
    float knpref;
    { const f32x2 kp = *(const f32x2*)(knp + ((size_t)bh * 64 + lane) * 2); float v = sqrtf(kp.x + kp.y) * 1.001f;
#pragma unroll
      for (int o = 1; o < 64; o <<= 1) { const float t = __shfl_up(v, o); if (lane >= o) v = fmaxf(v, t); }
      knpref = v; }
    f32x16 o0, o1;
#pragma unroll
    for (int i = 0; i < 16; ++i) { o0[i] = 0.f; o1[i] = 0.f; }
    float R = 0.f;
    const int nkb = (q0 + 128) / 64;
    const int srow = tid >> 3, sch = tid & 7;
    const bf16_t* sg = QKV + (rowbase + srow) * 1536 + 512 + (2 * hp) * 64 + sch * 8;
    const unsigned soff = srow * KPITCH + sch * 16;
    LAS unsigned* fl = (LAS unsigned*)(lds + 2 * ATT_BUF);
    u32x4 st0, st1, st2, st3;
#define ATT_LOAD(kb_) do { const bf16_t* g_ = sg + (size_t)(kb_) * 64 * 1536; st0 = *(const u32x4*)g_; st1 = *(const u32x4*)(g_ + 512); st2 = *(const u32x4*)(g_ + 64); st3 = *(const u32x4*)(g_ + 576); } while (0)
#define ATT_STORE(buf_) do { LAS unsigned char* d_ = lds + (buf_) * ATT_BUF + soff; *(LAS u32x4*)d_ = st0; *(LAS u32x4*)(d_ + KVBUF) = st1; *(LAS u32x4*)(d_ + 2 * KVBUF) = st2; *(LAS u32x4*)(d_ + 3 * KVBUF) = st3; } while (0)
    ATT_LOAD(nkb - 1); ATT_STORE(0);
    __syncthreads();
    const int vq = (lane & 15) >> 2, vp = lane & 3, vblk = (lane >> 4) & 1;
    const unsigned vlane = (4 * hi + vq) * KPITCH + vblk * 32 + vp * 8;
    const float lomask = hi ? 0.f : 1.f;
    for (int it = 0; it < nkb; ++it) {
        const int kb = nkb - 1 - it, cur = it & 1, s0 = kb * 64;
        const bool more = (it + 1 < nkb);
        if (more) ATT_LOAD(kb - 1);
        if (s0 < wq0 + 32) {
            const LAS unsigned char* Kb = lds + cur * ATT_BUF + hsel * (2 * KVBUF); const LAS unsigned char* Vb = Kb + KVBUF;
            f32x16 z0, z1;
#pragma unroll
            for (int i = 0; i < 16; ++i) { z0[i] = 0.f; z1[i] = 0.f; }
#pragma unroll
            for (int d0 = 0; d0 < 4; ++d0) {
                const bf16x8 ka = *(const LAS bf16x8*)(Kb + r32 * KPITCH + d0 * 32 + hi * 16);
                const bf16x8 kc = *(const LAS bf16x8*)(Kb + (32 + r32) * KPITCH + d0 * 32 + hi * 16);
                z0 = MFMA32(ka, qf[d0], z0); z1 = MFMA32(kc, qf[d0], z1);
            }
            if (s0 + 63 >= wq0) {
#pragma unroll
                for (int i = 0; i < 16; ++i) { const int kv = s0 + crow(i, hi); if (kv >= tq) z0[i] = -INFINITY; if (kv + 32 >= tq) z1[i] = -INFINITY; }
            }
            f32x16 c0, c1; float Glo[8], Ghi[8];
#pragma unroll
            for (int g = 0; g < 4; ++g) {
                float a3 = softplus2(z0[4 * g + 3]), a2 = softplus2(z0[4 * g + 2]) + a3, a1 = softplus2(z0[4 * g + 1]) + a2, a0 = softplus2(z0[4 * g]) + a1;
                c0[4 * g + 3] = a3; c0[4 * g + 2] = a2; c0[4 * g + 1] = a1; c0[4 * g] = a0;
                auto rr = __builtin_amdgcn_permlane32_swap(__float_as_uint(a0), __float_as_uint(a0), false, false);
                Glo[g] = __uint_as_float(rr[0]); Ghi[g] = __uint_as_float(rr[1]);
                float b3 = softplus2(z1[4 * g + 3]), b2 = softplus2(z1[4 * g + 2]) + b3, b1 = softplus2(z1[4 * g + 1]) + b2, b0 = softplus2(z1[4 * g]) + b1;
                c1[4 * g + 3] = b3; c1[4 * g + 2] = b2; c1[4 * g + 1] = b1; c1[4 * g] = b0;
                auto ss_ = __builtin_amdgcn_permlane32_swap(__float_as_uint(b0), __float_as_uint(b0), false, false);
                Glo[4 + g] = __uint_as_float(ss_[0]); Ghi[4 + g] = __uint_as_float(ss_[1]);
            }
            float run = R;
            u32x4 pf[2][2];
#pragma unroll
            for (int c = 7; c >= 0; --c) {
                const float base = __builtin_fmaf(Ghi[c], lomask, run);
                const int g = c & 3;
                float a[4];
                if (c >= 4) {
#pragma unroll
                    for (int j = 0; j < 4; ++j) a[j] = __builtin_amdgcn_exp2f(z1[4 * g + j] - (c1[4 * g + j] + base));
                    if (g & 1) { pf[1][g >> 1].z = pk2(a[0], a[1]); pf[1][g >> 1].w = pk2(a[2], a[3]); } else { pf[1][g >> 1].x = pk2(a[0], a[1]); pf[1][g >> 1].y = pk2(a[2], a[3]); }
                } else {
#pragma unroll
                    for (int j = 0; j < 4; ++j) a[j] = __builtin_amdgcn_exp2f(z0[4 * g + j] - (c0[4 * g + j] + base));
                    if (g & 1) { pf[0][g >> 1].z = pk2(a[0], a[1]); pf[0][g >> 1].w = pk2(a[2], a[3]); } else { pf[0][g >> 1].x = pk2(a[0], a[1]); pf[0][g >> 1].y = pk2(a[2], a[3]); }
                }
                run += Glo[c] + Ghi[c];
            }
            R = run;
#pragma unroll
            for (int kt = 0; kt < 2; ++kt)
#pragma unroll
                for (int s = 0; s < 2; ++s) {
                    const LAS unsigned char* vb = Vb + vlane + (32 * kt + 16 * s) * KPITCH;
                    const s16x4 l0 = vtr(vb), h0 = vtr(vb + 8 * KPITCH), l1 = vtr(vb + 64), h1 = vtr(vb + 64 + 8 * KPITCH);
                    const bf16x8 v0 = __builtin_shufflevector(l0, h0, 0, 1, 2, 3, 4, 5, 6, 7), v1 = __builtin_shufflevector(l1, h1, 0, 1, 2, 3, 4, 5, 6, 7);
                    const bf16x8 pb = __builtin_bit_cast(bf16x8, pf[kt][s]);
                    o0 = MFMA32(v0, pb, o0); o1 = MFMA32(v1, pb, o1);
                }
        }
        if (more) { ATT_STORE(cur ^ 1);
            const float kbound = __uint_as_float(__builtin_amdgcn_readlane(__float_as_uint(knpref), kb - 1));
            const bool ldone = (R - qn * kbound) > 160.f;
            if (lane == 0) fl[cur * 8 + wid] = __all(ldone) ? 1u : 0u; }
        __syncthreads();
        if (more) { const u32x4 fa = *(const LAS u32x4*)(fl + cur * 8), fb = *(const LAS u32x4*)(fl + cur * 8 + 4);
            if ((fa.x & fa.y & fa.z & fa.w & fb.x & fb.y & fb.z & fb.w) != 0u) break; }
    }
    __syncthreads();
#undef ATT_LOAD
#undef ATT_STORE
    bf16_t* op = OUT + (rowbase + tq) * D + CW + h * 64 + 4 * hi;
#pragma unroll
    for (int g = 0; g < 4; ++g) {
        u32x2 w0, w1; w0.x = pk2(o0[4 * g], o0[4 * g + 1]); w0.y = pk2(o0[4 * g + 2], o0[4 * g + 3]); w1.x = pk2(o1[4 * g], o1[4 * g + 1]); w1.y = pk2(o1[4 * g + 2], o1[4 * g + 3]);
        *(u32x2*)(op + 8 * g) = w0; *(u32x2*)(op + 32 + 8 * g) = w1;
    }
}

constexpr int CT = 64, CROWS = 96, CW_OFF = CROWS * 1024, CWROWS = 36;
DI void conv_load_w(const float* cw, LAS unsigned char* lds) {
    f32x2 wv[CWROWS * CW / 2 / 512];
#pragma unroll
    for (int k = 0; k < CWROWS * CW / 2 / 512; ++k) { const int i = threadIdx.x + 512 * k; wv[k] = (f32x2){0.f, 0.f}; if (i < CK * CW / 2) wv[k] = *(const f32x2*)(cw + 2 * i); }
#pragma unroll
    for (int k = 0; k < CWROWS * CW / 2 / 512; ++k) { const int i = threadIdx.x + 512 * k; *(LAS unsigned*)(lds + CW_OFF + 4 * i) = pk2(wv[k].x, wv[k].y); }
}
DI void unpack8(const u32x4 w, f32x2 (&o)[4]) { o[0] = (f32x2){bf_lo(w.x), bf_hi(w.x)}; o[1] = (f32x2){bf_lo(w.y), bf_hi(w.y)}; o[2] = (f32x2){bf_lo(w.z), bf_hi(w.z)}; o[3] = (f32x2){bf_lo(w.w), bf_hi(w.w)}; }
DI void conv_item(const bf16_t* U, bf16_t* OUT, const float* cb, const float* lg, const float* lb, LAS unsigned char* lds, int item) {
    const int tid = threadIdx.x, lane = tid & 63, wave = tid >> 6;
    const int b = item >> 6, t0 = (item & 63) * CT; const size_t rowbase = (size_t)b * SEQ;
    __syncthreads();
    { u32x4 tv[CROWS * 64 / 512];
#pragma unroll
      for (int k = 0; k < CROWS * 64 / 512; ++k) { const int i = tid + 512 * k, r = i >> 6, c16 = i & 63, s = t0 - (CK - 1) + r;
          tv[k] = (u32x4){0u, 0u, 0u, 0u}; if (s >= 0 && r < CT + CK - 1) tv[k] = *(const u32x4*)(U + (rowbase + s) * CW + c16 * 8); }
#pragma unroll
      for (int k = 0; k < CROWS * 64 / 512; ++k) { const int i = tid + 512 * k; *(LAS u32x4*)(lds + (i >> 6) * 1024 + (i & 63) * 16) = tv[k]; } }
    __syncthreads();
    f32x2 bias[4], g8[4], b8[4];
#pragma unroll
    for (int j = 0; j < 4; ++j) { bias[j] = *(const f32x2*)(cb + lane * 8 + 2 * j); g8[j] = *(const f32x2*)(lg + lane * 8 + 2 * j); b8[j] = *(const f32x2*)(lb + lane * 8 + 2 * j); }
    for (int grp = 0; grp < 2; ++grp) {
        const int t4 = wave * 8 + grp * 4;
        f32x2 acc[4][4], wv[4][4];
#pragma unroll
        for (int i = 0; i < 4; ++i)
#pragma unroll
            for (int j = 0; j < 4; ++j) { acc[i][j] = bias[j]; wv[i][j] = (f32x2){0.f, 0.f}; }
#pragma unroll 1
        for (int rb = 0; rb < CWROWS; rb += 4) {
#pragma unroll
            for (int q = 0; q < 4; ++q) {
                f32x2 u8[4]; unpack8(*(const LAS u32x4*)(lds + (t4 + rb + q) * 1024 + lane * 16), u8);
                unpack8(*(const LAS u32x4*)(lds + CW_OFF + (rb + q) * 1024 + lane * 16), wv[q]);
#pragma unroll
                for (int i = 0; i < 4; ++i)
#pragma unroll
                    for (int j = 0; j < 4; ++j) acc[i][j] = acc[i][j] + wv[(q - i) & 3][j] * u8[j];
            }
        }
#pragma unroll
        for (int i = 0; i < 4; ++i) {
            float s = 0.f;
#pragma unroll
            for (int j = 0; j < 4; ++j) s += acc[i][j].x + acc[i][j].y;
            const float mean = wave_sum(s) * (1.0f / CW); float s2 = 0.f;
#pragma unroll
            for (int j = 0; j < 4; ++j) { acc[i][j] = acc[i][j] - mean; s2 += acc[i][j].x * acc[i][j].x + acc[i][j].y * acc[i][j].y; }
            const float rstd = __builtin_amdgcn_rsqf(wave_sum(s2) * (1.0f / CW) + EPS);
            unsigned o[4];
#pragma unroll
            for (int j = 0; j < 4; ++j) { const f32x2 yv = acc[i][j] * rstd * g8[j] + b8[j]; o[j] = pk2(yv.x * fast_sigmoid(yv.x), yv.y * fast_sigmoid(yv.y)); }
            u32x4 w; w.x = o[0]; w.y = o[1]; w.z = o[2]; w.w = o[3];
            *(u32x4*)(OUT + (rowbase + t0 + t4 + i) * D + lane * 8) = w;
        }
    }
}

#ifndef MK_CG_ALL
#define MK_CG_ALL 0
#endif
#define PH_IN(k) (lo <= (k) && (k) < hi)
#define XB_TMO      128
#define XB_XCNT(j)  (256  + 64 * (j))
#define XB_XSUB(j)  (1280 + 64 * (j))
#define XB_XGEN(j)  (2304 + 64 * (j))
#define XB_TOP      3328
#define XB_TOPGEN   3392
#define XCD_BAR_WORDS 3456
#define XB_SPIN_CAP (1u << 18)
DI unsigned xb_ld(unsigned* p)              { return __hip_atomic_load(p, __ATOMIC_RELAXED, __HIP_MEMORY_SCOPE_AGENT); }
DI unsigned xb_add(unsigned* p, unsigned v) { return __hip_atomic_fetch_add(p, v, __ATOMIC_RELAXED, __HIP_MEMORY_SCOPE_AGENT); }
DI unsigned xb_xcc_id() { return (unsigned)__builtin_amdgcn_s_getreg((3 << 11) | 20) & 0xFu; }
#define XB_SPIN(cond, bar) do { unsigned _sp = 0; while (cond) { __builtin_amdgcn_s_sleep(1); \
    if ((++_sp & 255u) == 0u) { if (xb_ld(&(bar)[XB_TMO])) break; if (_sp > XB_SPIN_CAP) { atomicAdd(&(bar)[XB_TMO], 1u); break; } } } } while (0)
struct XcdBarrier { unsigned* bar; unsigned x; volatile LAS unsigned* st; };
DI XcdBarrier xcd_barrier_post(unsigned* bar, volatile LAS unsigned* st) {
    XcdBarrier b; b.bar = bar; b.x = xb_xcc_id(); b.st = st;
    if (threadIdx.x == 0) (void)xb_add(&bar[XB_XCNT(b.x)], 1u);
    return b;
}
DI void xcd_barrier_complete(unsigned* bar, unsigned x, unsigned& nloc, unsigned& nx) {
    const unsigned G = gridDim.x * gridDim.y * gridDim.z;
    unsigned sum, cnt, mine, sp = 0u;
    for (;;) {
        sum = 0u; cnt = 0u; mine = 0u;
#pragma unroll
        for (unsigned j = 0; j < 16; ++j) { const unsigned c = xb_ld(&bar[XB_XCNT(j)]); sum += c; cnt += (c > 0u) ? 1u : 0u; mine = (j == x) ? c : mine; }
        if (sum == G) break;
        __builtin_amdgcn_s_sleep(1);
        if ((++sp & 255u) == 0u) { if (xb_ld(&bar[XB_TMO])) break; if (sp > XB_SPIN_CAP) { atomicAdd(&bar[XB_TMO], 1u); break; } }
    }
    nloc = mine > 0u ? mine : 1u; nx = cnt > 0u ? cnt : 1u;
}
DI void xcd_barrier(const XcdBarrier& b) {
    asm volatile("s_waitcnt vmcnt(0)" ::: "memory");
    __syncthreads();
    if (threadIdx.x == 0) {
        unsigned* bar = b.bar;
        __builtin_amdgcn_s_waitcnt(0);
        unsigned nloc = b.st[0], nx = b.st[1];
        if (nloc == 0u) { xcd_barrier_complete(bar, b.x, nloc, nx); b.st[0] = nloc; b.st[1] = nx; }
        const unsigned old = xb_add(&bar[XB_XSUB(b.x)], 1u);
        const unsigned gen = old / nloc;
        if (old + 1u == (gen + 1u) * nloc) {
            __builtin_amdgcn_fence(__ATOMIC_RELEASE, "agent");
            asm volatile("s_waitcnt vmcnt(0)" ::: "memory");
            const unsigned og = xb_add(&bar[XB_TOP], 1u);
            const unsigned tg = og / nx;
            if (og + 1u == (tg + 1u) * nx) xb_add(&bar[XB_TOPGEN], 1u);
            else XB_SPIN(xb_ld(&bar[XB_TOPGEN]) == tg, bar);
            __builtin_amdgcn_fence(__ATOMIC_ACQUIRE, "agent");
            xb_add(&bar[XB_XGEN(b.x)], 1u);
            asm volatile("s_waitcnt vmcnt(0)" ::: "memory");
        } else {
            XB_SPIN(xb_ld(&bar[XB_XGEN(b.x)]) == gen, bar);
            __builtin_amdgcn_fence(__ATOMIC_ACQUIRE, "agent");
            asm volatile("s_waitcnt vmcnt(0)" ::: "memory");
        }
    }
    __syncthreads();
}
#ifndef MK_DUP
#define MK_DUP 0
#endif
#define PH_SEAM(k) do { if (PH_IN(k) && PH_IN((k) + 1)) { if (MK_CG_ALL || p.out == nullptr) grid.sync(); else xcd_barrier(bar);     } } while (0)
template <int L>
DI void layer_phases(const Params& p, LAS unsigned char* lds, const int lo, const int hi, cg::grid_group& grid, const XcdBarrier& bar) {
    unsigned char* ws = p.ws;
    float* mod = (float*)(ws + OFF_MOD); float* ssb = (float*)(ws + OFF_SS);
    bf16_t* H = (bf16_t*)(ws + OFF_H); bf16_t* MIX = (bf16_t*)(ws + OFF_MIX); bf16_t* XB = (bf16_t*)(ws + OFF_XB);
    bf16_t* Ub = (bf16_t*)(ws + OFF_U); bf16_t* QKV = (bf16_t*)(ws + OFF_QKV); bf16_t* RATIO = (bf16_t*)(ws + OFF_RATIO); bf16_t* SGA = (bf16_t*)(ws + OFF_SGA); bf16_t* HID = (bf16_t*)(ws + OFF_HID);
    const float* modl = mod + (size_t)L * NB * 6144;
    constexpr int P0 = 2 + 8 * L;
    if (PH_IN(P0)) { pg8::StaticOrder S; EpiIn E{Ub, QKV, RATIO, SGA, (float*)(ws + OFF_KN)}; S.init(M, INC, gridDim.x, blockIdx.x);
        for (int rep = 0; rep < ((L == 0 && (MK_DUP & 4)) ? 2 : 1); ++rep) pg8::gemm_phase(lds, pg8::Gemm{H, (const bf16_t*)(ws + OFF_WIN) + (size_t)L * INC * D, M, INC, D}, S, E); }
    PH_SEAM(P0);
    if (PH_IN(P0 + 1)) for (int rep = 0; rep < ((L == 0 && (MK_DUP & 2)) ? 2 : 1); ++rep) {
        __syncthreads();
        for (int it = blockIdx.x; it < 2048; it += gridDim.x) attn_block(QKV, (const float*)(ws + OFF_KN), MIX, lds, it >> 7, (it >> 5) & 3, it & 31);
        conv_load_w(p.conv_w + (size_t)L * CK * CW, lds);
        for (int it = blockIdx.x; it < 1024; it += gridDim.x)
            conv_item(Ub, MIX, p.conv_b + L * CW, p.conv_ln_g + L * CW, p.conv_ln_b + L * CW, lds, it);
    }
    PH_SEAM(P0 + 1);
    if (PH_IN(P0 + 2)) { pg8::StaticOrder S; EpiMix E{RATIO, SGA, H}; S.init(M, D, gridDim.x, blockIdx.x);
        for (int rep = 0; rep < ((L == 0 && (MK_DUP & 4)) ? 2 : 1); ++rep) pg8::gemm_phase(lds, pg8::Gemm{MIX, (const bf16_t*)(ws + OFF_WMIX) + (size_t)L * D * D, M, D, D}, S, E); }
    PH_SEAM(P0 + 2);
    if (PH_IN(P0 + 3)) { pg8::StaticOrder S; EpiY E{MIX, ssb + (size_t)(2 * L) * M * 16}; S.init(M, D, gridDim.x, blockIdx.x);
        for (int rep = 0; rep < ((L == 0 && (MK_DUP & 4)) ? 2 : 1); ++rep) pg8::gemm_phase(lds, pg8::Gemm{H, (const bf16_t*)(ws + OFF_WO) + (size_t)L * D * D, M, D, D}, S, E); }
    PH_SEAM(P0 + 3);
    if (PH_IN(P0 + 4)) rowpass(p.x, L == 0 ? nullptr : XB, MIX, ssb + (size_t)(2 * L) * M * 16, modl + 2048, p.post_mix_g + L * D, nullptr, XB, p.pre_ffn_g + L * D, modl + 4096, modl + 3072, H);
    PH_SEAM(P0 + 4);
    if (PH_IN(P0 + 5)) { pg8::StaticOrder S; EpiF1 E{HID}; S.init(M, 2 * DFF, gridDim.x, blockIdx.x);
        for (int rep = 0; rep < ((L == 0 && (MK_DUP & 4)) ? 2 : 1); ++rep) pg8::gemm_phase(lds, pg8::Gemm{H, (const bf16_t*)(ws + OFF_WF1) + (size_t)L * 2 * DFF * D, M, 2 * DFF, D}, S, E); }
    PH_SEAM(P0 + 5);
    if (PH_IN(P0 + 6)) { pg8::StaticOrder S; EpiY E{MIX, ssb + (size_t)(2 * L + 1) * M * 16}; S.init(M, D, gridDim.x, blockIdx.x);
        for (int rep = 0; rep < ((L == 0 && (MK_DUP & 4)) ? 2 : 1); ++rep) pg8::gemm_phase(lds, pg8::Gemm{HID, (const bf16_t*)(ws + OFF_WF2) + (size_t)L * D * DFF, M, D, DFF}, S, E); }
    PH_SEAM(P0 + 6);
    if (PH_IN(P0 + 7)) { constexpr bool lastl = (L == DEPTH - 1); const float* modn = modl + (size_t)NB * 6144;
        rowpass(nullptr, XB, MIX, ssb + (size_t)(2 * L + 1) * M * 16, modl + 5120, p.post_ffn_g + L * D, p.out, lastl ? nullptr : XB,
                lastl ? nullptr : p.pre_mix_g + (lastl ? 0 : L + 1) * D, modn + 1024, modn, H); }
    if (L + 1 < DEPTH) PH_SEAM(P0 + 7);
}

__global__ __launch_bounds__(512, 2) void fwd_megakernel(Params p) {
    extern __shared__ __attribute__((aligned(16))) unsigned char shm[];
    LAS unsigned char* lds = (LAS unsigned char*)shm;
    cg::grid_group grid = cg::this_grid();
    const int lo = p.ph_lo, hi = p.ph_hi;
    volatile LAS unsigned* st = (volatile LAS unsigned*)(lds + 135168);
    if (threadIdx.x < 4) st[threadIdx.x] = 0u;
    __syncthreads();
    XcdBarrier bar; bar.bar = (unsigned*)(p.ws + OFF_BAR); bar.x = 0; bar.st = st;
    if (hi - lo > 2) bar = xcd_barrier_post((unsigned*)(p.ws + OFF_BAR), st);
    if (PH_IN(0)) { phase0(p, lds); if (MK_DUP & 1) { __syncthreads(); phase0(p, lds); } }
    PH_SEAM(0);
    if (PH_IN(1)) { float* mod = (float*)(p.ws + OFF_MOD); for (int rep = 0; rep < ((MK_DUP & 1) ? 2 : 1); ++rep) rowpass(p.x, nullptr, nullptr, nullptr, nullptr, nullptr, nullptr, nullptr, p.pre_mix_g, mod + 1024, mod, (bf16_t*)(p.ws + OFF_H)); }
    PH_SEAM(1);
    layer_phases<0>(p, lds, lo, hi, grid, bar);
    layer_phases<1>(p, lds, lo, hi, grid, bar);
}


#ifndef MK_CHECK
#define MK_CHECK 0
#endif
#if MK_CHECK
DI float bfr(float x) { return bf_lo(pk2(x, 0.f)); }
DI float ldbf(const bf16_t* p) { return __uint_as_float(((unsigned)*p) << 16); }
DI unsigned hsh(unsigned x) { x ^= x >> 16; x *= 0x7feb352du; x ^= x >> 15; x *= 0x846ca68bu; x ^= x >> 16; return x; }
DI void diag_max(const Params& p, int stage, float got, float ref) {
    float e = fabsf(got - ref) / (fabsf(ref) + 0.05f); if (!(e == e)) e = 1e9f;
    atomicMax((unsigned*)(p.ws + OFF_DIAG) + stage, __float_as_uint(e));
}
DI float dotA(const bf16_t* a, const float* w, int ldw, int K) { float s = 0.f; for (int k = 0; k < K; ++k) s += ldbf(a + k) * bfr(w[(size_t)k * ldw]); return s; }
DI float sigm(float x) { return 1.0f / (1.0f + expf(-x)); }
__global__ void chk_kernel(Params p, int stage) {
    const unsigned id = blockIdx.x * blockDim.x + threadIdx.x; const unsigned h1 = hsh(id * 2654435761u + stage * 977u), h2 = hsh(h1 + 12345u);
    unsigned char* ws = p.ws; const float* mod = (const float*)(ws + OFF_MOD); const float* ssb = (const float*)(ws + OFF_SS);
    const bf16_t* H = (const bf16_t*)(ws + OFF_H); const bf16_t* MIX = (const bf16_t*)(ws + OFF_MIX); const bf16_t* Ub = (const bf16_t*)(ws + OFF_U); const bf16_t* QKV = (const bf16_t*)(ws + OFF_QKV);
    const bf16_t* RATIO = (const bf16_t*)(ws + OFF_RATIO); const bf16_t* SGA = (const bf16_t*)(ws + OFF_SGA); const bf16_t* HID = (const bf16_t*)(ws + OFF_HID);
    int row = h1 % M; if ((id & 7) == 0) row = (row & ~4095) + (h2 % 40); const int b = row >> 12;
    if (stage == 1) { const int l = id & 1, bb = (id >> 1) & 15, col = h1 % 6144; float s = p.ada_b[l * 6144 + col];
        for (int k = 0; k < D; ++k) { const float c = p.c[bb * D + k]; s += c * sigm(c) * p.ada_w[((size_t)l * D + k) * 6144 + col]; }
        diag_max(p, 1, mod[(l * NB + bb) * 6144 + col], s); }
    if (stage == 2) { float q = 0.f; for (int k = 0; k < D; ++k) { const float v = p.x[(size_t)row * D + k]; q += v * v; }
        const float rs = 1.0f / sqrtf(q / D + EPS); const int col = h2 % D;
        const float ref = p.x[(size_t)row * D + col] * rs * p.pre_mix_g[col] * (1.0f + mod[b * 6144 + 1024 + col]) + mod[b * 6144 + col];
        diag_max(p, 2, ldbf(H + (size_t)row * D + col), ref); }
    if (stage == 3) { const bf16_t* a = H + (size_t)row * D; const int t = id & 3;
        if (t == 0) { const int ch = h2 % CW; const float v = dotA(a, p.w_in + ch, INC, D), g = dotA(a, p.w_in + 512 + ch, INC, D); diag_max(p, 3, ldbf(Ub + (size_t)row * CW + ch), v * sigm(g)); }
        else if (t == 1) { const int c = h2 % 1536; const float v = dotA(a, p.w_in + 1024 + c, INC, D) * (c < 512 ? 0.125f * LOG2E : 1.0f); diag_max(p, 3, ldbf(QKV + (size_t)row * 1536 + c), v); }
        else { const int ch = h2 % D; const float gc = dotA(a, p.w_in + 2560 + ch, INC, D), ga = dotA(a, p.w_in + 3584 + ch, INC, D);
            if (t == 2) diag_max(p, 3, ldbf(RATIO + (size_t)row * D + ch), sigm(gc) / sigm(ga)); else diag_max(p, 3, ldbf(SGA + (size_t)row * D + ch), sigm(ga)); } }
    if (stage == 4) { const int s0 = row & 4095; float s1 = 0.f, s2 = 0.f; const int chs = h2 % CW; float vs = 0.f;
        for (int ch = 0; ch < CW; ++ch) { float a = p.conv_b[ch];
            for (int k = 0; k < CK; ++k) { const int s = s0 - 30 + k; if (s >= 0) a += bfr(p.conv_w[k * CW + ch]) * ldbf(Ub + ((size_t)(row - s0 + s)) * CW + ch); }
            s1 += a; s2 += a * a; if (ch == chs) vs = a; }
        const float mean = s1 / CW, var = s2 / CW - mean * mean; const float yv = (vs - mean) / sqrtf(var + EPS) * p.conv_ln_g[chs] + p.conv_ln_b[chs];
        diag_max(p, 4, ldbf(MIX + (size_t)row * D + chs), yv * sigm(yv)); }
    if (stage == 5) { const int hh = h2 & 7, d4 = ((h2 >> 3) & 15) * 4; int t = row & 4095; if ((id & 3) == 1) t &= 255; if ((id & 3) == 2) t &= 63; const size_t rb = (size_t)b * SEQ;
        const bf16_t* q = QKV + (rb + t) * 1536 + hh * 64; float o0 = 0.f, o1 = 0.f, o2 = 0.f, o3 = 0.f, run = 0.f;
        for (int s = t - 1; s >= 0; --s) { const bf16_t* kk = QKV + (rb + s) * 1536 + 512 + hh * 64; float z = 0.f; for (int d = 0; d < 64; ++d) z += ldbf(q + d) * ldbf(kk + d);
            run += fmaxf(z, 0.f) + log2f(1.0f + exp2f(-fabsf(z))); const float a = exp2f(z - run); const bf16_t* vv = kk + 512 + d4;
            o0 += a * ldbf(vv); o1 += a * ldbf(vv + 1); o2 += a * ldbf(vv + 2); o3 += a * ldbf(vv + 3); if (run > 200.f) break; }
        const bf16_t* o = MIX + (rb + t) * D + CW + hh * 64 + d4;
        diag_max(p, 5, ldbf(o), o0); diag_max(p, 5, ldbf(o + 1), o1); diag_max(p, 5, ldbf(o + 2), o2); diag_max(p, 5, ldbf(o + 3), o3); }
    if (stage == 6) { const int col = h2 % D; const bf16_t* a = MIX + (size_t)row * D; const float yc = dotA(a, p.w_conv_out + col, D, CW), ya = dotA(a + CW, p.w_att_out + col, D, CW);
        diag_max(p, 6, ldbf(H + (size_t)row * D + col), ldbf(SGA + (size_t)row * D + col) * (ldbf(RATIO + (size_t)row * D + col) * yc + ya)); }
    if (stage == 7 || stage == 10) { const int col = h2 % D; const bool f = (stage == 10);
        const float ref = f ? dotA(HID + (size_t)row * DFF, p.w_ffn_out + col, D, DFF) : dotA(H + (size_t)row * D, p.w_o + col, D, D);
        diag_max(p, stage, ldbf(MIX + (size_t)row * D + col), ref);
        if ((id & 15) == 0) { float q = 0.f; for (int k = 0; k < D; ++k) { const float v = ldbf(MIX + (size_t)row * D + k); q += v * v; } float sq = 0.f; for (int k = 0; k < 16; ++k) sq += ssb[((size_t)(f ? M : 0) + row) * 16 + k]; diag_max(p, stage, sq, q); } }
    if (stage == 8 || stage == 11) { const bool f = (stage == 11); const int col = h2 % D; const float* xin = f ? p.out : p.x;
        float sq = 0.f; for (int k = 0; k < 16; ++k) sq += ssb[((size_t)(f ? M : 0) + row) * 16 + k];
        const float rs = 1.0f / sqrtf(sq / D + EPS);
        if (!f) { const float ref = xin[(size_t)row * D + col] + mod[b * 6144 + 2048 + col] * ldbf(MIX + (size_t)row * D + col) * rs * p.post_mix_g[col]; diag_max(p, 8, p.out[(size_t)row * D + col], ref); }
        float q = 0.f; for (int k = 0; k < D; ++k) { const float v = p.out[(size_t)row * D + k]; q += v * v; }
        const float r2 = 1.0f / sqrtf(q / D + EPS);
        const float ref = f ? p.out[(size_t)row * D + col] * r2 * p.pre_mix_g[D + col] * (1.0f + mod[(NB + b) * 6144 + 1024 + col]) + mod[(NB + b) * 6144 + col]
                            : p.out[(size_t)row * D + col] * r2 * p.pre_ffn_g[col] * (1.0f + mod[b * 6144 + 4096 + col]) + mod[b * 6144 + 3072 + col];
        diag_max(p, stage, ldbf(H + (size_t)row * D + col), ref); }
    if (stage == 9) { const int ch = h2 % DFF; const bf16_t* a = H + (size_t)row * D; const float g = dotA(a, p.w_ffn_in + ch, 2 * DFF, D), u = dotA(a, p.w_ffn_in + DFF + ch, 2 * DFF, D);
        diag_max(p, 9, ldbf(HID + (size_t)row * DFF + ch), g * sigm(g) * u); }
}
__global__ void chk_report(Params p) {
    const unsigned* dg = (const unsigned*)(p.ws + OFF_DIAG); int first = 0, second = 0;
    for (int s = 1; s <= 11; ++s) if (__uint_as_float(dg[s]) > 0.04f) { if (!first) first = s; else if (!second) second = s; }
    if (first) p.out[0] = 1000.0f * (10 * (first % 10) + (second % 10)) + (first >= 10 ? 500.f : 0.f);
}
#endif

#ifndef MK_PER_PHASE
#define MK_PER_PHASE 0
#endif
extern "C" void kernel_launch(void* const* d_in, const int* in_sizes, int n_in, void* d_out, int out_size, void* d_ws, size_t ws_size, hipStream_t stream) {
    static int grid = 0;
    if (grid == 0) {
        if (n_in != 18 || in_sizes[0] != M * D || out_size != M * D || ws_size < WS_END) { fprintf(stderr, "kernel_launch: unexpected shapes (n_in %d in0 %d out %d ws %zu need %zu)\n", n_in, in_sizes[0], out_size, ws_size, (size_t)WS_END); grid = -1; return; }
        int dev = 0, cus = 0, per_cu = 0;
        hipGetDevice(&dev); hipDeviceGetAttribute(&cus, hipDeviceAttributeMultiprocessorCount, dev);
        if (hipFuncSetAttribute((const void*)fwd_megakernel, hipFuncAttributeMaxDynamicSharedMemorySize, LDS_BYTES) != hipSuccess) { fprintf(stderr, "kernel_launch: hipFuncSetAttribute failed\n"); grid = -1; return; }
        if (hipOccupancyMaxActiveBlocksPerMultiprocessor(&per_cu, (const void*)fwd_megakernel, 512, LDS_BYTES) != hipSuccess || per_cu < 1) { fprintf(stderr, "kernel_launch: occupancy query failed (%d)\n", per_cu); (void)hipGetLastError(); per_cu = 1; }
        grid = cus * per_cu;
    }
    if (grid < 0) return;
    (void)hipMemsetAsync((unsigned char*)d_ws + OFF_DIAG, 0, ZERO_BYTES, stream);
    Params p{};
    const float** pp = (const float**)&p;
    for (int i = 0; i < 18; ++i) pp[i] = (const float*)d_in[i];
    p.out = (float*)d_out; p.ws = (unsigned char*)d_ws;
#if MK_PER_PHASE
    for (int ph = 0; ph < NPHASE; ++ph) { p.ph_lo = ph; p.ph_hi = ph + 1;
        hipLaunchKernelGGL(fwd_megakernel, dim3(grid), dim3(512), LDS_BYTES, stream, p);
#if MK_CHECK
        { Params q = p; q.ph_lo = 0; q.ph_hi = 0;
          auto CH = [&](int st) { hipLaunchKernelGGL(chk_kernel, dim3(8), dim3(64), 0, stream, q, st); };
          if (ph == 1) { CH(1); CH(2); } if (ph == 2) CH(3); if (ph == 3) { CH(4); CH(5); } if (ph == 4) CH(6); if (ph == 5) CH(7); if (ph == 6) CH(8);
          if (ph == 7) CH(9); if (ph == 8) CH(10); if (ph == 9) CH(11);
          if (ph == NPHASE - 1) hipLaunchKernelGGL(chk_report, dim3(1), dim3(1), 0, stream, q); }
#endif
    }
#else
    p.ph_lo = 0; p.ph_hi = NPHASE;
    void* args[] = {&p};
    hipError_t e = hipLaunchCooperativeKernel((const void*)fwd_megakernel, dim3(grid), dim3(512), args, LDS_BYTES, stream);
    if (e != hipSuccess) fprintf(stderr, "cooperative launch failed: %s (grid %d)\n", hipGetErrorString(e), grid);
#endif
}
```

```cpp
#include <hip/hip_runtime.h>
#include <hip/hip_cooperative_groups.h>
#include <cstdio>
#include <cstdint>
namespace cg = cooperative_groups;

#define DI __device__ __forceinline__
#define LAS __attribute__((address_space(3)))
typedef unsigned short bf16_t;
typedef short bf16x8 __attribute__((ext_vector_type(8)));
typedef short s16x4 __attribute__((ext_vector_type(4)));
typedef float f32x2 __attribute__((ext_vector_type(2)));
typedef float f32x4 __attribute__((ext_vector_type(4)));
typedef float f32x16 __attribute__((ext_vector_type(16)));
typedef unsigned u32x2 __attribute__((ext_vector_type(2)));
typedef unsigned u32x4 __attribute__((ext_vector_type(4)));
typedef __bf16 bf2_t __attribute__((ext_vector_type(2)));

constexpr int D = 1024, NB = 16, SEQ = 4096, M = NB * SEQ, DEPTH = 2;
constexpr int CW = 512, CK = 31, NH = 8, HD = 64, DFF = 2816, INC = 4608;
constexpr float EPS = 1e-6f;
constexpr float LOG2E = 1.4426950408889634f;
constexpr int LDS_BYTES = 135168 + 64;
constexpr int NPHASE = 2 + 8 * DEPTH;

constexpr size_t OFF_MOD = 0;
constexpr size_t OFF_DIAG = 786432;
constexpr size_t OFF_BAR = OFF_DIAG + 256;
constexpr size_t ZERO_BYTES = 256 + 3456 * 4;
constexpr size_t OFF_KN = 802816;
constexpr size_t OFF_WIN = 2097152;
constexpr size_t OFF_WMIX = OFF_WIN + 2ull * INC * D * 2;
constexpr size_t OFF_WO = OFF_WMIX + 2ull * D * D * 2;
constexpr size_t OFF_WF1 = OFF_WO + 2ull * D * D * 2;
constexpr size_t OFF_WF2 = OFF_WF1 + 2ull * 2 * DFF * D * 2;
constexpr size_t OFF_H = 67108864;
constexpr size_t OFF_MIX = OFF_H + (size_t)M * D * 2;
constexpr size_t OFF_R = OFF_MIX + (size_t)M * D * 2;
constexpr size_t OFF_U = OFF_R;
constexpr size_t OFF_QKV = OFF_U + (size_t)M * CW * 2;
constexpr size_t OFF_RATIO = OFF_QKV + (size_t)M * 1536 * 2;
constexpr size_t OFF_SGA = OFF_RATIO + (size_t)M * D * 2;
constexpr size_t OFF_HID = OFF_R;
constexpr size_t WS_END_ACT = OFF_SGA + (size_t)M * D * 2;
constexpr size_t OFF_SS = WS_END_ACT;
constexpr size_t OFF_XB = WS_END_ACT + 4ull * M * 16 * 4;
constexpr size_t WS_END = OFF_XB + (size_t)M * D * 2;
static_assert(OFF_WF2 + 2ull * D * DFF * 2 <= OFF_H, "weights overflow");
static_assert(OFF_HID + (size_t)M * DFF * 2 <= WS_END, "hid overflow");

struct Params {
    const float *x, *c, *ada_w, *ada_b, *pre_mix_g, *post_mix_g, *pre_ffn_g, *post_ffn_g, *w_in, *conv_w, *conv_b, *conv_ln_g, *conv_ln_b,
        *w_conv_out, *w_att_out, *w_o, *w_ffn_in, *w_ffn_out;
    float* out; unsigned char* ws; int ph_lo, ph_hi;
};

DI unsigned pk2(float a, float b) { f32x2 v = {a, b}; bf2_t r = __builtin_convertvector(v, bf2_t); return __builtin_bit_cast(unsigned, r); }
DI float bf_lo(unsigned w) { return __uint_as_float(w << 16); }
DI float bf_hi(unsigned w) { return __uint_as_float(w & 0xffff0000u); }
DI float fast_sigmoid(float x) { return __builtin_amdgcn_rcpf(1.0f + __builtin_amdgcn_exp2f(-x * LOG2E)); }
DI float wave_sum(float v) {
#pragma unroll
    for (int o = 1; o < 64; o <<= 1) v += __shfl_xor(v, o);
    return v;
}

namespace pg8 {
constexpr int BM = 256, BK = 64, HALF = 128, HTB = HALF * BK * 2, STAGE_BYTES = 8 * HTB, NXCD = 8, WGM = 4;
DI int lds_byte(int r, int c) { const int st = (r >> 4) * 2 + (c >> 5), rr = r & 15, cc = c & 31, ob = rr * 64 + cc * 2; return st * 1024 + (ob ^ (((ob >> 9) & 1) << 5)); }
DI void stage_rc(int b, int& R, int& C) { const int st = b / 1024, sb = b % 1024, swz = sb ^ (((sb >> 9) & 1) << 5); R = (st >> 1) * 16 + swz / 64; C = (st & 1) * 32 + (swz % 64) / 2; }
DI int perm32(int rho) { const int n = rho >> 4, i = rho & 15; return 8 * (i >> 2) + 4 * n + (i & 3); }
struct Unit { int pm, pn; };
struct Gemm { const bf16_t* A; const bf16_t* Bt; int M, N, K; };
struct StaticOrder {
    int nM, nN, nwg, G, c;
    DI void init(int M_, int N_, int G_, int c_) { nM = M_ / BM; nN = N_ / BM; nwg = nM * nN; G = G_; c = c_; }
    DI bool next(int i, Unit& u) const {
        const long L = (long)i * G + c; if (L >= nwg) return false;
        int wgid = (int)L; { const int q = nwg / NXCD, r = nwg % NXCD, xcd = wgid % NXCD, off = wgid / NXCD; wgid = (xcd < r ? xcd * (q + 1) : r * (q + 1) + (xcd - r) * q) + off; }
        const int nig = WGM * nN, gid = wgid / nig, fm = gid * WGM, gsz = (nM - fm) < WGM ? (nM - fm) : WGM;
        u.pm = fm + ((wgid % nig) % gsz); u.pn = (wgid % nig) / gsz; return true;
    }
};
#ifndef MK_ALIGN
#define MK_ALIGN true
#endif
#ifndef MK_SP2
#define MK_SP2 true
#endif
template <class Epi, bool ALIGN_EPI = MK_ALIGN, bool SP2 = MK_SP2>
DI void gemm_phase(LAS unsigned char* lds, const Gemm g, const StaticOrder& S, const Epi& E) {
    const int tid = threadIdx.x, wid = __builtin_amdgcn_readfirstlane(tid >> 6), lane = tid & 63, wr = wid >> 2, wc = wid & 3, fr = lane & 15, fq = lane >> 4;
    const int K = g.K, nt = K / BK;
    unsigned voffA[2];
#pragma unroll
    for (int i = 0; i < 2; ++i) { int R, C; stage_rc(tid * 16 + i * 8192, R, C); voffA[i] = (unsigned)(R * K + C) * 2u; }
    const size_t kstep = (size_t)(BK * 2);
    const size_t hstep = (size_t)HALF * K * 2;
    const size_t tstep = 2 * hstep;
    const unsigned ldsw = (unsigned)wid * 1024u;
    const int aoff = lds_byte(wr * 64 + fr, fq * 8), boff = lds_byte(wc * 32 + fr, fq * 8);
#define PG8_SA(b, h) (((b) * 2 + (h)) * HTB)
#define PG8_SB(b, h) ((4 + (b) * 2 + (h)) * HTB)
#define PG8_STAGE(bufoff, gbase) do { _Pragma("unroll") for (int _i = 0; _i < 2; ++_i) \
        __builtin_amdgcn_global_load_lds((const unsigned*)((const char*)(gbase) + voffA[_i]), (LAS unsigned*)(lds + (bufoff) + ldsw + _i * 8192), 16, 0, 0); } while (0)
#define PG8_LDA(dst, b, h) do { _Pragma("unroll") for (int m = 0; m < 4; ++m) _Pragma("unroll") for (int k = 0; k < 2; ++k) dst[m][k] = *(const LAS bf16x8*)(lds + PG8_SA(b, h) + aoff + m * 2048 + k * 1024); } while (0)
#define PG8_LDB(dst, b, h) do { _Pragma("unroll") for (int n = 0; n < 2; ++n) _Pragma("unroll") for (int k = 0; k < 2; ++k) dst[n][k] = *(const LAS bf16x8*)(lds + PG8_SB(b, h) + boff + n * 2048 + k * 1024); } while (0)
#define PG8_MMA(ai, bj, At, Bt) do { __builtin_amdgcn_s_setprio(1); _Pragma("unroll") for (int m = 0; m < 4; ++m) _Pragma("unroll") for (int n = 0; n < 2; ++n) _Pragma("unroll") for (int k = 0; k < 2; ++k) \
        acc[ai][bj][m][n] = __builtin_amdgcn_mfma_f32_16x16x32_bf16(Bt[n][k], At[m][k], acc[ai][bj][m][n], 0, 0, 0); __builtin_amdgcn_s_setprio(0); } while (0)
#define PG8_WAIT_V(n) asm volatile("s_waitcnt vmcnt(" #n ")" ::: "memory")
#define PG8_WAIT_L(n) asm volatile("s_waitcnt lgkmcnt(" #n ")" ::: "memory")
#define PG8_BAR __builtin_amdgcn_s_barrier()
#define PG8_SCHED __builtin_amdgcn_sched_barrier(0)
    Unit cur, nxt; int ui = 0;
    if (!S.next(0, cur)) return;
    f32x4 acc[2][2][4][2];
#pragma unroll
    for (int a = 0; a < 2; ++a)
#pragma unroll
        for (int b = 0; b < 2; ++b)
#pragma unroll
            for (int m = 0; m < 4; ++m)
#pragma unroll
                for (int n = 0; n < 2; ++n) acc[a][b][m][n] = (f32x4){0.f, 0.f, 0.f, 0.f};
    bf16x8 At[4][2], B0[2][2], B1[2][2];
    const char* cA = (const char*)g.A + (size_t)cur.pm * tstep; const char* cB = (const char*)g.Bt + (size_t)cur.pn * tstep;
    if constexpr (SP2) {
        PG8_STAGE(PG8_SB(0, 0), cB); PG8_STAGE(PG8_SB(0, 1), cB + hstep); PG8_STAGE(PG8_SA(0, 0), cA); PG8_STAGE(PG8_SA(0, 1), cA + hstep);
        if (wr == 1) PG8_BAR;
        PG8_WAIT_V(2); PG8_BAR;
        PG8_STAGE(PG8_SB(1, 0), cB + kstep); PG8_STAGE(PG8_SA(1, 0), cA + kstep); PG8_STAGE(PG8_SB(1, 1), cB + hstep + kstep);
        PG8_WAIT_V(6); PG8_BAR;
    } else {
        PG8_STAGE(PG8_SB(0, 0), cB); PG8_STAGE(PG8_SA(0, 0), cA); PG8_STAGE(PG8_SB(0, 1), cB + hstep); PG8_STAGE(PG8_SA(0, 1), cA + hstep);
        if (wr == 1) PG8_BAR;
        PG8_WAIT_V(4); PG8_BAR;
        PG8_STAGE(PG8_SB(1, 0), cB + kstep); PG8_STAGE(PG8_SA(1, 0), cA + kstep); PG8_STAGE(PG8_SB(1, 1), cB + hstep + kstep);
        PG8_WAIT_V(6); PG8_BAR;
    }
    for (;;) {
        const bool has_next = S.next(ui + 1, nxt);
        const char* nA = has_next ? (const char*)g.A + (size_t)nxt.pm * tstep : cA; const char* nB = has_next ? (const char*)g.Bt + (size_t)nxt.pn * tstep : cB;
        for (int t = 0; t < nt; t += 2) {
            if constexpr (Epi::MIDK) { if (t == (nt >> 1)) E.mid(acc, cur, wr, wc, fr, fq); }
            const bool last = (t == nt - 2);
            const char* a1 = cA + (size_t)(t + 1) * kstep;
            const char* a2 = last ? nA : cA + (size_t)(t + 2) * kstep; const char* b2 = last ? nB : cB + (size_t)(t + 2) * kstep;
            const char* a3 = a2 + kstep; const char* b3 = b2 + kstep;
            if constexpr (SP2) {
            PG8_LDB(B0, 0, 0); PG8_LDB(B1, 0, 1); PG8_SCHED; PG8_LDA(At, 0, 0); PG8_STAGE(PG8_SA(1, 1), a1 + hstep);
            PG8_WAIT_V(8); PG8_WAIT_L(0); PG8_BAR; PG8_MMA(0, 0, At, B0); PG8_MMA(0, 1, At, B1); PG8_BAR; PG8_SCHED;
            PG8_LDA(At, 0, 1); PG8_STAGE(PG8_SB(0, 0), b2); PG8_STAGE(PG8_SB(0, 1), b2 + hstep); PG8_STAGE(PG8_SA(0, 0), a2);
            PG8_WAIT_V(8); PG8_WAIT_L(0); PG8_BAR; PG8_MMA(1, 0, At, B0); PG8_MMA(1, 1, At, B1); PG8_BAR; PG8_SCHED;
            PG8_LDB(B0, 1, 0); PG8_LDB(B1, 1, 1); PG8_SCHED; PG8_LDA(At, 1, 0); PG8_STAGE(PG8_SA(0, 1), a2 + hstep);
            PG8_WAIT_V(8); PG8_WAIT_L(0); PG8_BAR; PG8_MMA(0, 0, At, B0); PG8_MMA(0, 1, At, B1); PG8_BAR; PG8_SCHED;
            PG8_LDA(At, 1, 1); PG8_STAGE(PG8_SB(1, 0), b3); PG8_STAGE(PG8_SB(1, 1), b3 + hstep); PG8_STAGE(PG8_SA(1, 0), a3);
            PG8_WAIT_V(8); PG8_WAIT_L(0); PG8_BAR; PG8_MMA(1, 0, At, B0); PG8_MMA(1, 1, At, B1); PG8_BAR; PG8_SCHED;
            } else {
            PG8_LDB(B0, 0, 0); PG8_SCHED; PG8_LDA(At, 0, 0); PG8_STAGE(PG8_SA(1, 1), a1 + hstep);
            PG8_WAIT_L(8); PG8_BAR; PG8_WAIT_L(0); PG8_MMA(0, 0, At, B0); PG8_BAR; PG8_SCHED;
            PG8_LDB(B1, 0, 1); PG8_STAGE(PG8_SB(0, 0), b2);
            PG8_BAR; PG8_WAIT_L(0); PG8_MMA(0, 1, At, B1); PG8_BAR;
            PG8_LDA(At, 0, 1); PG8_STAGE(PG8_SA(0, 0), a2);
            PG8_BAR; PG8_WAIT_L(0); PG8_MMA(1, 0, At, B0); PG8_BAR; PG8_SCHED;
            PG8_STAGE(PG8_SB(0, 1), b2 + hstep);
            PG8_WAIT_V(6); PG8_BAR; PG8_MMA(1, 1, At, B1); PG8_BAR;
            PG8_LDB(B0, 1, 0); PG8_SCHED; PG8_LDA(At, 1, 0); PG8_STAGE(PG8_SA(0, 1), a2 + hstep);
            PG8_WAIT_L(8); PG8_BAR; PG8_WAIT_L(0); PG8_MMA(0, 0, At, B0); PG8_BAR; PG8_SCHED;
            PG8_LDB(B1, 1, 1); PG8_STAGE(PG8_SB(1, 0), b3);
            PG8_BAR; PG8_WAIT_L(0); PG8_MMA(0, 1, At, B1); PG8_BAR;
            PG8_LDA(At, 1, 1); PG8_STAGE(PG8_SA(1, 0), a3);
            PG8_BAR; PG8_WAIT_L(0); PG8_MMA(1, 0, At, B0); PG8_BAR; PG8_SCHED;
            PG8_STAGE(PG8_SB(1, 1), b3 + hstep);
            PG8_WAIT_V(6); PG8_BAR; PG8_MMA(1, 1, At, B1); PG8_BAR;
            }
        }
        if constexpr (ALIGN_EPI) { if (wr == 0) PG8_BAR; }
        E(acc, cur, wr, wc, fr, fq);
        if (!has_next) break;
#pragma unroll
        for (int a = 0; a < 2; ++a)
#pragma unroll
            for (int b = 0; b < 2; ++b)
#pragma unroll
                for (int m = 0; m < 4; ++m)
#pragma unroll
                    for (int n = 0; n < 2; ++n) acc[a][b][m][n] = (f32x4){0.f, 0.f, 0.f, 0.f};
        cur = nxt; cA = nA; cB = nB; ++ui;
        if constexpr (ALIGN_EPI) { if (wr == 1) PG8_BAR; }
    }
    PG8_WAIT_V(0);
    if constexpr (!ALIGN_EPI) { if (wr == 0) PG8_BAR; }
    PG8_BAR;
#undef PG8_SA
#undef PG8_SB
#undef PG8_STAGE
#undef PG8_LDA
#undef PG8_LDB
#undef PG8_MMA
#undef PG8_WAIT_V
#undef PG8_WAIT_L
#undef PG8_BAR
#undef PG8_SCHED
}
}
using pg8::Unit;
typedef f32x4 AccT[2][2][4][2];

struct EpiIn {
    static constexpr bool MIDK = false;
    bf16_t *U, *QKV, *RATIO, *SGA; float* KN;
    DI void mid(AccT&, const Unit&, int, int, int, int) const {}
    DI void operator()(const AccT& acc, const Unit& u, int wr, int wc, int fr, int fq) const {
        const int row0 = u.pm * 256 + wr * 64 + fr;
        if (u.pn < 4) {
#pragma unroll
            for (int ai = 0; ai < 2; ++ai)
#pragma unroll
                for (int m = 0; m < 4; ++m) { const size_t row = (size_t)(row0 + ai * 128 + m * 16); const int ch0 = u.pn * 128 + wc * 32 + fq * 8; float o[8];
#pragma unroll
                    for (int n = 0; n < 2; ++n) { const f32x4 a = acc[ai][0][m][n], gt = acc[ai][1][m][n];
#pragma unroll
                        for (int j = 0; j < 4; ++j) o[4 * n + j] = a[j] * fast_sigmoid(gt[j]); }
                    u32x4 w; w.x = pk2(o[0], o[1]); w.y = pk2(o[2], o[3]); w.z = pk2(o[4], o[5]); w.w = pk2(o[6], o[7]);
                    *(u32x4*)(U + row * CW + ch0) = w; }
        } else if (u.pn < 10) {
            const float sc = (u.pn < 6) ? (0.125f * LOG2E) : 1.0f;
#pragma unroll
            for (int ai = 0; ai < 2; ++ai)
#pragma unroll
                for (int m = 0; m < 4; ++m) { const size_t row = (size_t)(row0 + ai * 128 + m * 16);
#pragma unroll
                    for (int bj = 0; bj < 2; ++bj) { const int col0 = (u.pn - 4) * 256 + wc * 64 + bj * 32 + fq * 8;
                        const f32x4 v0 = acc[ai][bj][m][0] * sc, v1 = acc[ai][bj][m][1] * sc;
                        u32x4 w; w.x = pk2(v0[0], v0[1]); w.y = pk2(v0[2], v0[3]); w.z = pk2(v1[0], v1[1]); w.w = pk2(v1[2], v1[3]);
                        *(u32x4*)(QKV + row * 1536 + col0) = w; } }
            if (u.pn == 6 || u.pn == 7) {
#pragma unroll
                for (int ai = 0; ai < 2; ++ai)
#pragma unroll
                    for (int bj = 0; bj < 2; ++bj) { float mx = 0.f;
#pragma unroll
                        for (int m = 0; m < 4; ++m) { const f32x4 v0 = acc[ai][bj][m][0], v1 = acc[ai][bj][m][1]; float q = 0.f;
#pragma unroll
                            for (int j = 0; j < 4; ++j) { const float a = bf_lo(pk2(v0[j], 0.f)), c = bf_lo(pk2(v1[j], 0.f)); q += a * a + c * c; }
                            q += __shfl_xor(q, 16); q += __shfl_xor(q, 32); mx = fmaxf(mx, q); }
#pragma unroll
                        for (int o = 1; o < 16; o <<= 1) mx = fmaxf(mx, __shfl_xor(mx, o));
                        const int rowb = u.pm * 256 + ai * 128 + wr * 64, hh = (u.pn - 6) * 4 + wc;
                        if ((fr | fq) == 0) KN[((size_t)(((rowb >> 12) * 8 + hh) * 64 + ((rowb & 4095) >> 6))) * 2 + bj] = mx; }
            }
        } else {
#pragma unroll
            for (int ai = 0; ai < 2; ++ai)
#pragma unroll
                for (int m = 0; m < 4; ++m) { const size_t row = (size_t)(row0 + ai * 128 + m * 16); const int ch0 = (u.pn - 10) * 128 + wc * 32 + fq * 8; float r[8], s[8];
#pragma unroll
                    for (int n = 0; n < 2; ++n) { const f32x4 gc = acc[ai][0][m][n], ga = acc[ai][1][m][n];
#pragma unroll
                        for (int j = 0; j < 4; ++j) { const float ea = 1.0f + __builtin_amdgcn_exp2f(-fmaxf(ga[j], -80.f) * LOG2E);
                            s[4 * n + j] = __builtin_amdgcn_rcpf(ea); r[4 * n + j] = fast_sigmoid(gc[j]) * ea; } }
                    u32x4 wr_, ws_; wr_.x = pk2(r[0], r[1]); wr_.y = pk2(r[2], r[3]); wr_.z = pk2(r[4], r[5]); wr_.w = pk2(r[6], r[7]);
                    ws_.x = pk2(s[0], s[1]); ws_.y = pk2(s[2], s[3]); ws_.z = pk2(s[4], s[5]); ws_.w = pk2(s[6], s[7]);
                    *(u32x4*)(RATIO + row * D + ch0) = wr_; *(u32x4*)(SGA + row * D + ch0) = ws_; }
        }
    }
};
struct EpiMix {
    static constexpr bool MIDK = true;
    const bf16_t *RATIO, *SGA; bf16_t* O;
    DI void scale(AccT& acc, const bf16_t* T, const Unit& u, int wr, int wc, int fr, int fq) const {
        int row0 = u.pm * 256 + wr * 64 + fr; asm volatile("" : "+v"(row0));
        const bf16_t* Tp = T + (size_t)row0 * D + u.pn * 256 + wc * 64 + fq * 8;
#pragma unroll
        for (int ai = 0; ai < 2; ++ai)
#pragma unroll
            for (int m = 0; m < 4; ++m) {
#pragma unroll
                for (int bj = 0; bj < 2; ++bj) {
                    const u32x4 w = *(const u32x4*)(Tp + (ai * 128 + m * 16) * D + bj * 32);
                    acc[ai][bj][m][0] *= (f32x4){bf_lo(w.x), bf_hi(w.x), bf_lo(w.y), bf_hi(w.y)};
                    acc[ai][bj][m][1] *= (f32x4){bf_lo(w.z), bf_hi(w.z), bf_lo(w.w), bf_hi(w.w)}; } }
    }
    DI void mid(AccT& acc, const Unit& u, int wr, int wc, int fr, int fq) const { scale(acc, RATIO, u, wr, wc, fr, fq); }
    DI void operator()(AccT& acc, const Unit& u, int wr, int wc, int fr, int fq) const {
        scale(acc, SGA, u, wr, wc, fr, fq);
        const int row0 = u.pm * 256 + wr * 64 + fr;
#pragma unroll
        for (int ai = 0; ai < 2; ++ai)
#pragma unroll
            for (int m = 0; m < 4; ++m) { const size_t row = (size_t)(row0 + ai * 128 + m * 16);
#pragma unroll
                for (int bj = 0; bj < 2; ++bj) { const int col0 = u.pn * 256 + wc * 64 + bj * 32 + fq * 8;
                    const f32x4 v0 = acc[ai][bj][m][0], v1 = acc[ai][bj][m][1];
                    u32x4 w; w.x = pk2(v0[0], v0[1]); w.y = pk2(v0[2], v0[3]); w.z = pk2(v1[0], v1[1]); w.w = pk2(v1[2], v1[3]);
                    *(u32x4*)(O + row * D + col0) = w; } }
    }
};
struct EpiY {
    static constexpr bool MIDK = false;
    bf16_t* Y; float* ss;
    DI void mid(AccT&, const Unit&, int, int, int, int) const {}
    DI void operator()(const AccT& acc, const Unit& u, int wr, int wc, int fr, int fq) const {
        const int row0 = u.pm * 256 + wr * 64 + fr;
#pragma unroll
        for (int ai = 0; ai < 2; ++ai)
#pragma unroll
            for (int m = 0; m < 4; ++m) { const size_t row = (size_t)(row0 + ai * 128 + m * 16); float q = 0.f;
#pragma unroll
                for (int bj = 0; bj < 2; ++bj) { const int col0 = u.pn * 256 + wc * 64 + bj * 32 + fq * 8;
                    const f32x4 v0 = acc[ai][bj][m][0], v1 = acc[ai][bj][m][1];
                    q += (v0[0] * v0[0] + v0[1] * v0[1]) + (v0[2] * v0[2] + v0[3] * v0[3]) + (v1[0] * v1[0] + v1[1] * v1[1]) + (v1[2] * v1[2] + v1[3] * v1[3]);
                    u32x4 w; w.x = pk2(v0[0], v0[1]); w.y = pk2(v0[2], v0[3]); w.z = pk2(v1[0], v1[1]); w.w = pk2(v1[2], v1[3]);
                    *(u32x4*)(Y + row * D + col0) = w; }
                q += __shfl_xor(q, 16); q += __shfl_xor(q, 32);
                if (fq == 0) ss[row * 16 + u.pn * 4 + wc] = q; }
    }
};
struct EpiF1 {
    static constexpr bool MIDK = false;
    bf16_t* HID;
    DI void mid(AccT&, const Unit&, int, int, int, int) const {}
    DI void operator()(const AccT& acc, const Unit& u, int wr, int wc, int fr, int fq) const {
        const int row0 = u.pm * 256 + wr * 64 + fr;
#pragma unroll
        for (int ai = 0; ai < 2; ++ai)
#pragma unroll
            for (int m = 0; m < 4; ++m) { const size_t row = (size_t)(row0 + ai * 128 + m * 16); const int ch0 = u.pn * 128 + wc * 32 + fq * 8; float o[8];
#pragma unroll
                for (int n = 0; n < 2; ++n) { const f32x4 gt = acc[ai][0][m][n], up = acc[ai][1][m][n];
#pragma unroll
                    for (int j = 0; j < 4; ++j) o[4 * n + j] = gt[j] * fast_sigmoid(gt[j]) * up[j]; }
                u32x4 w; w.x = pk2(o[0], o[1]); w.y = pk2(o[2], o[3]); w.z = pk2(o[4], o[5]); w.w = pk2(o[6], o[7]);
                *(u32x4*)(HID + row * DFF + ch0) = w; }
    }
};

DI int src_pair(int np, int second_off) { const int pn = np >> 8, tc = np & 255, bj = tc >> 7, wc = (tc >> 5) & 3; return pn * 128 + wc * 32 + pg8::perm32(tc & 31) + bj * second_off; }
DI int src_nat(int np) { const int tc = np & 255; return (np & ~255) + ((tc >> 5) & 3) * 64 + (tc >> 7) * 32 + pg8::perm32(tc & 31); }
DI void tr_item(const float* W, int ldw, bf16_t* WT, int Kd, int kdst0, int ksrc0, int n0, int srccol, LAS float* scr, int lane) {
    const float* src = W + (size_t)ksrc0 * ldw + srccol;
#pragma unroll 8
    for (int i = 0; i < 32; ++i) { const int kk = 2 * i + (lane >> 5); scr[kk * 33 + (lane & 31)] = src[(size_t)kk * ldw]; }
    asm volatile("s_waitcnt lgkmcnt(0)" ::: "memory");
    const int c = lane & 7;
#pragma unroll
    for (int j = 0; j < 4; ++j) { const int n = (lane >> 3) + 8 * j; const LAS float* s = scr + (8 * c) * 33 + n;
        u32x4 o; o.x = pk2(s[0 * 33], s[1 * 33]); o.y = pk2(s[2 * 33], s[3 * 33]); o.z = pk2(s[4 * 33], s[5 * 33]); o.w = pk2(s[6 * 33], s[7 * 33]);
        *(u32x4*)(WT + (size_t)(n0 + n) * Kd + kdst0 + 8 * c) = o; }
    asm volatile("s_waitcnt lgkmcnt(0)" ::: "memory");
}
constexpr int TR_IN = 16 * 144, TR_MIX = 16 * 32, TR_O = 16 * 32, TR_F1 = 16 * 176, TR_F2 = 44 * 32, TR_LAYER = TR_IN + TR_MIX + TR_O + TR_F1 + TR_F2;
constexpr int MOD_ITEMS = 2 * 96 * 4;
DI void phase0(const Params& p, LAS unsigned char* lds) {
    const int lane = threadIdx.x & 63, wave = threadIdx.x >> 6;
    LAS float* scr = (LAS float*)(lds + wave * 16384);
    const int gw = blockIdx.x * 8 + wave, NGW = gridDim.x * 8;
    for (int q = blockIdx.x; q < 192; q += gridDim.x) {
        const int kc = wave, l = q / 96, col = (q % 96) * 64 + lane;
        const float* W = p.ada_w + (size_t)l * D * 6144 + col;
        float acc[16];
#pragma unroll
        for (int b = 0; b < 16; ++b) acc[b] = 0.f;
        for (int k0 = kc * 128; k0 < kc * 128 + 128; k0 += 16) {
            float w[16], sv[4];
#pragma unroll
            for (int kq = 0; kq < 16; ++kq) w[kq] = W[(size_t)(k0 + kq) * 6144];
#pragma unroll
            for (int g = 0; g < 4; ++g) { const float cv = p.c[(lane & 15) * D + k0 + 4 * g + (lane >> 4)]; sv[g] = cv * fast_sigmoid(cv); }
#pragma unroll
            for (int kq = 0; kq < 16; ++kq)
#pragma unroll
                for (int b = 0; b < 16; ++b) acc[b] += __uint_as_float(__builtin_amdgcn_readlane(__float_as_uint(sv[kq >> 2]), b + 16 * (kq & 3))) * w[kq];
        }
        LAS float* part = (LAS float*)lds;
#pragma unroll
        for (int b = 0; b < 16; ++b) part[(wave * 16 + b) * 64 + lane] = acc[b];
        __syncthreads();
        if (wave < 2) { float* mo = (float*)(p.ws + OFF_MOD) + (size_t)l * NB * 6144 + col; const float bias = p.ada_b[l * 6144 + col];
#pragma unroll
            for (int bb = 0; bb < 8; ++bb) { const int b = wave * 8 + bb; float t = 0.f;
#pragma unroll
                for (int w8 = 0; w8 < 8; ++w8) t += part[(w8 * 16 + b) * 64 + lane];
                mo[b * 6144] = t + bias; } }
        __syncthreads();
    }
    for (int it = gw + MOD_ITEMS; it < MOD_ITEMS + 2 * TR_LAYER; it += NGW) {
        {
            int r = it - MOD_ITEMS; const int l = r / TR_LAYER; r -= l * TR_LAYER;
            if (r < TR_IN) { const int kb = r / 144, nb = r % 144, n0 = nb * 32, np = n0 + (lane & 31);
                const int sc = np < 1024 ? src_pair(np, 512) : (np < 2560 ? src_nat(np) : 2560 + src_pair(np - 2560, 1024));
                tr_item(p.w_in + (size_t)l * D * INC, INC, (bf16_t*)(p.ws + OFF_WIN) + (size_t)l * INC * D, D, kb * 64, kb * 64, n0, sc, scr, lane); continue; }
            r -= TR_IN;
            if (r < TR_MIX) { const int kb = r / 32, nb = r % 32, n0 = nb * 32, sc = src_nat(n0 + (lane & 31));
                const float* W = kb < 8 ? p.w_conv_out + (size_t)l * CW * D : p.w_att_out + (size_t)l * CW * D;
                tr_item(W, D, (bf16_t*)(p.ws + OFF_WMIX) + (size_t)l * D * D, D, kb * 64, (kb & 7) * 64, n0, sc, scr, lane); continue; }
            r -= TR_MIX;
            if (r < TR_O) { const int kb = r / 32, nb = r % 32, n0 = nb * 32, sc = src_nat(n0 + (lane & 31));
                tr_item(p.w_o + (size_t)l * D * D, D, (bf16_t*)(p.ws + OFF_WO) + (size_t)l * D * D, D, kb * 64, kb * 64, n0, sc, scr, lane); continue; }
            r -= TR_O;
            if (r < TR_F1) { const int kb = r / 176, nb = r % 176, n0 = nb * 32, sc = src_pair(n0 + (lane & 31), DFF);
                tr_item(p.w_ffn_in + (size_t)l * D * 2 * DFF, 2 * DFF, (bf16_t*)(p.ws + OFF_WF1) + (size_t)l * 2 * DFF * D, D, kb * 64, kb * 64, n0, sc, scr, lane); continue; }
            r -= TR_F1;
            { const int kb = r / 32, nb = r % 32, n0 = nb * 32, sc = src_nat(n0 + (lane & 31));
                tr_item(p.w_ffn_out + (size_t)l * DFF * D, D, (bf16_t*)(p.ws + OFF_WF2) + (size_t)l * D * DFF, DFF, kb * 64, kb * 64, n0, sc, scr, lane); }
        }
    }
}

DI void rowpass(const float* xin, const bf16_t* xinb, const bf16_t* y, const float* ss, const float* gate, const float* postg, float* xout, bf16_t* xoutb,
                const float* gnext, const float* scn, const float* shn, bf16_t* hout) {
    const int lane = threadIdx.x & 63, wave = threadIdx.x >> 6;
    const int gw = blockIdx.x * 8 + wave, NGW = gridDim.x * 8;
    constexpr int NR = 4, RPW = 32;
    for (int base = gw * RPW; base < M; base += NGW * RPW) {
        const int b = base >> 12;
        f32x4 c1[4], c2[4], c3[4];
#pragma unroll
        for (int j = 0; j < 4; ++j) { const int col = 4 * lane + 256 * j;
            c1[j] = y ? *(const f32x4*)(gate + b * 6144 + col) * *(const f32x4*)(postg + col) : (f32x4){0.f, 0.f, 0.f, 0.f};
            if (gnext) { c2[j] = *(const f32x4*)(gnext + col) * (1.0f + *(const f32x4*)(scn + b * 6144 + col)); c3[j] = *(const f32x4*)(shn + b * 6144 + col); }
            else { c2[j] = (f32x4){0.f, 0.f, 0.f, 0.f}; c3[j] = c2[j]; } }
        for (int r0 = 0; r0 < RPW; r0 += NR) {
            f32x4 v[NR][4]; u32x2 yw[NR][4]; float sq[NR];
#pragma unroll
            for (int q = 0; q < NR; ++q) { const size_t row = (size_t)(base + r0 + q);
#pragma unroll
                for (int j = 0; j < 4; ++j) {
                    if (xinb) { const u32x2 w = *(const u32x2*)(xinb + row * D + 4 * lane + 256 * j); v[q][j] = (f32x4){bf_lo(w.x), bf_hi(w.x), bf_lo(w.y), bf_hi(w.y)}; }
                    else v[q][j] = *(const f32x4*)(xin + row * D + 4 * lane + 256 * j); }
                if (y) { sq[q] = lane < 16 ? ss[row * 16 + lane] : 0.f;
#pragma unroll
                    for (int j = 0; j < 4; ++j) yw[q][j] = *(const u32x2*)(y + row * D + 4 * lane + 256 * j); } }
#pragma unroll
            for (int q = 0; q < NR; ++q) { const size_t row = (size_t)(base + r0 + q);
                if (y) {
                    const float rs = __builtin_amdgcn_rsqf(wave_sum(sq[q]) * (1.0f / D) + EPS);
#pragma unroll
                    for (int j = 0; j < 4; ++j) { const int col = 4 * lane + 256 * j; const u32x2 w = yw[q][j];
                        const f32x4 yv = {bf_lo(w.x), bf_hi(w.x), bf_lo(w.y), bf_hi(w.y)};
                        v[q][j] += (yv * rs) * c1[j];
                        if (xoutb) { u32x2 wo; wo.x = pk2(v[q][j].x, v[q][j].y); wo.y = pk2(v[q][j].z, v[q][j].w); *(u32x2*)(xoutb + row * D + col) = wo; }
                        else *(f32x4*)(xout + row * D + col) = v[q][j]; }
                }
                if (gnext) {
                    float s = 0.f;
#pragma unroll
                    for (int j = 0; j < 4; ++j) s += (v[q][j].x * v[q][j].x + v[q][j].y * v[q][j].y) + (v[q][j].z * v[q][j].z + v[q][j].w * v[q][j].w);
                    const float r = __builtin_amdgcn_rsqf(wave_sum(s) * (1.0f / D) + EPS);
#pragma unroll
                    for (int j = 0; j < 4; ++j) { const int col = 4 * lane + 256 * j;
                        const f32x4 hv = (v[q][j] * r) * c2[j] + c3[j];
                        u32x2 w; w.x = pk2(hv.x, hv.y); w.y = pk2(hv.z, hv.w);
                        *(u32x2*)(hout + row * D + col) = w; }
                }
            }
        }
    }
}

DI int crow(int r, int hi) { return (r & 3) + 8 * (r >> 2) + 4 * hi; }
#define MFMA32(a, b, c) __builtin_amdgcn_mfma_f32_32x32x16_bf16((a), (b), (c), 0, 0, 0)
typedef short v4i16_t __attribute__((ext_vector_type(4)));
DI s16x4 vtr(const LAS unsigned char* p) { return __builtin_bit_cast(s16x4, __builtin_amdgcn_ds_read_tr16_b64_v4i16((LAS v4i16_t*)p)); }
DI float softplus2(float z) {
    return fmaxf(z, 0.f) + __builtin_amdgcn_logf(1.0f + __builtin_amdgcn_exp2f(-fabsf(z)));
}
constexpr int KPITCH = 144, KVBUF = 64 * KPITCH;
DI void attn_wave(const bf16_t* QKV, const float* knp, bf16_t* OUT, LAS unsigned char* vl, int bh, int qb) {
    const int lane = threadIdx.x & 63, r32 = lane & 31, hi = lane >> 5;
    const int b = bh >> 3, h = bh & 7; const size_t rowbase = (size_t)b * SEQ;
    const int wq0 = qb * 32, tq = wq0 + r32;
    bf16x8 qf[4];
    { const bf16_t* qp = QKV + (rowbase + tq) * 1536 + h * 64 + hi * 8;
#pragma unroll
      for (int d0 = 0; d0 < 4; ++d0) qf[d0] = *(const bf16x8*)(qp + d0 * 16); }
    float qn;
    { float s = 0.f;
#pragma unroll
      for (int d0 = 0; d0 < 4; ++d0) { const u32x4 w = __builtin_bit_cast(u32x4, qf[d0]);
          s += bf_lo(w.x) * bf_lo(w.x) + bf_hi(w.x) * bf_hi(w.x) + bf_lo(w.y) * bf_lo(w.y) + bf_hi(w.y) * bf_hi(w.y) + bf_lo(w.z) * bf_lo(w.z) + bf_hi(w.z) * bf_hi(w.z) + bf_lo(w.w) * bf_lo(w.w) + bf_hi(w.w) * bf_hi(w.w); }
      auto rr = __builtin_amdgcn_permlane32_swap(__float_as_uint(s), __float_as_uint(s), false, false);
      qn = sqrtf(__uint_as_float(rr[0]) + __uint_as_float(rr[1])) * 1.001f; }
    float knpref;
    { const f32x2 kp = *(const f32x2*)(knp + ((size_t)bh * 64 + lane) * 2); float v = sqrtf(kp.x + kp.y) * 1.001f;
#pragma unroll
      for (int o = 1; o < 64; o <<= 1) { const float t = __shfl_up(v, o); if (lane >= o) v = fmaxf(v, t); }
      knpref = v; }
    f32x16 o0, o1;
#pragma unroll
    for (int i = 0; i < 16; ++i) { o0[i] = 0.f; o1[i] = 0.f; }
    float R = 0.f;
    int kb = (wq0 + 31) >> 6;
    const bf16_t* kbase = QKV + rowbase * 1536 + 512 + h * 64;
    bf16x8 ka[4], kc[4];
    { const bf16_t* kp = kbase + (size_t)(kb * 64 + r32) * 1536 + hi * 8;
#pragma unroll
      for (int d0 = 0; d0 < 4; ++d0) { ka[d0] = *(const bf16x8*)(kp + d0 * 16); kc[d0] = *(const bf16x8*)(kp + 32 * 1536 + d0 * 16); } }
    const int vq = (lane & 15) >> 2, vp = lane & 3, vblk = (lane >> 4) & 1;
    const unsigned vlane = (4 * hi + vq) * KPITCH + vblk * 32 + vp * 8;
    const unsigned vst = (lane >> 3) * KPITCH + (lane & 7) * 16;
    const float lomask = hi ? 0.f : 1.f;
    for (;;) {
        const int s0 = kb * 64;
        u32x4 vr[8];
        { const bf16_t* vp_ = kbase + 512 + (size_t)(s0 + (lane >> 3)) * 1536 + (lane & 7) * 8;
#pragma unroll
          for (int i = 0; i < 8; ++i) vr[i] = *(const u32x4*)(vp_ + (size_t)(8 * i) * 1536); }
        f32x16 z0, z1;
#pragma unroll
        for (int i = 0; i < 16; ++i) { z0[i] = 0.f; z1[i] = 0.f; }
#pragma unroll
        for (int d0 = 0; d0 < 4; ++d0) { z0 = MFMA32(ka[d0], qf[d0], z0); z1 = MFMA32(kc[d0], qf[d0], z1); }
        if (kb > 0) { const bf16_t* kp = kbase + (size_t)((kb - 1) * 64 + r32) * 1536 + hi * 8;
#pragma unroll
            for (int d0 = 0; d0 < 4; ++d0) { ka[d0] = *(const bf16x8*)(kp + d0 * 16); kc[d0] = *(const bf16x8*)(kp + 32 * 1536 + d0 * 16); } }
        if (s0 + 63 >= wq0) {
#pragma unroll
            for (int i = 0; i < 16; ++i) { const int kv = s0 + crow(i, hi); if (kv >= tq) z0[i] = -INFINITY; if (kv + 32 >= tq) z1[i] = -INFINITY; }
        }
        f32x16 c0, c1; float Glo[8], Ghi[8];
#pragma unroll
        for (int g = 0; g < 4; ++g) {
            float a3 = softplus2(z0[4 * g + 3]), a2 = softplus2(z0[4 * g + 2]) + a3, a1 = softplus2(z0[4 * g + 1]) + a2, a0 = softplus2(z0[4 * g]) + a1;
            c0[4 * g + 3] = a3; c0[4 * g + 2] = a2; c0[4 * g + 1] = a1; c0[4 * g] = a0;
            auto rr = __builtin_amdgcn_permlane32_swap(__float_as_uint(a0), __float_as_uint(a0), false, false);
            Glo[g] = __uint_as_float(rr[0]); Ghi[g] = __uint_as_float(rr[1]);
            float b3 = softplus2(z1[4 * g + 3]), b2 = softplus2(z1[4 * g + 2]) + b3, b1 = softplus2(z1[4 * g + 1]) + b2, b0 = softplus2(z1[4 * g]) + b1;
            c1[4 * g + 3] = b3; c1[4 * g + 2] = b2; c1[4 * g + 1] = b1; c1[4 * g] = b0;
            auto ss_ = __builtin_amdgcn_permlane32_swap(__float_as_uint(b0), __float_as_uint(b0), false, false);
            Glo[4 + g] = __uint_as_float(ss_[0]); Ghi[4 + g] = __uint_as_float(ss_[1]);
        }
        float run = R;
        u32x4 pf[2][2];
#pragma unroll
        for (int c = 7; c >= 0; --c) {
            const float base = __builtin_fmaf(Ghi[c], lomask, run);
            const int g = c & 3;
            float a[4];
            if (c >= 4) {
#pragma unroll
                for (int j = 0; j < 4; ++j) a[j] = __builtin_amdgcn_exp2f(z1[4 * g + j] - (c1[4 * g + j] + base));
                if (g & 1) { pf[1][g >> 1].z = pk2(a[0], a[1]); pf[1][g >> 1].w = pk2(a[2], a[3]); } else { pf[1][g >> 1].x = pk2(a[0], a[1]); pf[1][g >> 1].y = pk2(a[2], a[3]); }
            } else {
#pragma unroll
                for (int j = 0; j < 4; ++j) a[j] = __builtin_amdgcn_exp2f(z0[4 * g + j] - (c0[4 * g + j] + base));
                if (g & 1) { pf[0][g >> 1].z = pk2(a[0], a[1]); pf[0][g >> 1].w = pk2(a[2], a[3]); } else { pf[0][g >> 1].x = pk2(a[0], a[1]); pf[0][g >> 1].y = pk2(a[2], a[3]); }
            }
            run += Glo[c] + Ghi[c];
        }
        R = run;
#pragma unroll
        for (int i = 0; i < 8; ++i) *(LAS u32x4*)(vl + vst + i * 8 * KPITCH) = vr[i];
#pragma unroll
        for (int kt = 0; kt < 2; ++kt)
#pragma unroll
            for (int s = 0; s < 2; ++s) {
                const LAS unsigned char* vb = vl + vlane + (32 * kt + 16 * s) * KPITCH;
                const s16x4 l0 = vtr(vb), h0 = vtr(vb + 8 * KPITCH), l1 = vtr(vb + 64), h1 = vtr(vb + 64 + 8 * KPITCH);
                const bf16x8 v0 = __builtin_shufflevector(l0, h0, 0, 1, 2, 3, 4, 5, 6, 7), v1 = __builtin_shufflevector(l1, h1, 0, 1, 2, 3, 4, 5, 6, 7);
                const bf16x8 pb = __builtin_bit_cast(bf16x8, pf[kt][s]);
                o0 = MFMA32(v0, pb, o0); o1 = MFMA32(v1, pb, o1);
            }
        if (kb == 0) break;
        const float kbound = __uint_as_float(__builtin_amdgcn_readlane(__float_as_uint(knpref), kb - 1));
        if (__all((R - qn * kbound) > 160.f)) break;
        --kb;
    }
    bf16_t* op = OUT + (rowbase + tq) * D + CW + h * 64 + 4 * hi;
#pragma unroll
    for (int g = 0; g < 4; ++g) {
        u32x2 w0, w1; w0.x = pk2(o0[4 * g], o0[4 * g + 1]); w0.y = pk2(o0[4 * g + 2], o0[4 * g + 3]); w1.x = pk2(o1[4 * g], o1[4 * g + 1]); w1.y = pk2(o1[4 * g + 2], o1[4 * g + 3]);
        *(u32x2*)(op + 8 * g) = w0; *(u32x2*)(op + 32 + 8 * g) = w1;
    }
}

constexpr int ATT_BUF = 4 * KVBUF;
DI void attn_block(const bf16_t* QKV, const float* knp, bf16_t* OUT, LAS unsigned char* lds, int b, int hp, int qt) {
    const int tid = threadIdx.x, lane = tid & 63, r32 = lane & 31, hi = lane >> 5; const int wid = __builtin_amdgcn_readfirstlane(tid >> 6);
    const int hsel = wid >> 2, h = 2 * hp + hsel, bh = b * 8 + h; const size_t rowbase = (size_t)b * SEQ;
    const int q0 = qt * 128, wq0 = q0 + (wid & 3) * 32, tq = wq0 + r32;
    bf16x8 qf[4];
    { const bf16_t* qp = QKV + (rowbase + tq) * 1536 + h * 64 + hi * 8;
#pragma unroll
      for (int d0 = 0; d0 < 4; ++d0) qf[d0] = *(const bf16x8*)(qp + d0 * 16); }
    float qn;
    { float s = 0.f;
#pragma unroll
      for (int d0 = 0; d0 < 4; ++d0) { const u32x4 w = __builtin_bit_cast(u32x4, qf[d0]);
          s += bf_lo(w.x) * bf_lo(w.x) + bf_hi(w.x) * bf_hi(w.x) + bf_lo(w.y) * bf_lo(w.y) + bf_hi(w.y) * bf_hi(w.y) + bf_lo(w.z) * bf_lo(w.z) + bf_hi(w.z) * bf_hi(w.z) + bf_lo(w.w) * bf_lo(w.w) + bf_hi(w.w) * bf_hi(w.w); }
      auto rr = __builtin_amdgcn_permlane32_swap(__float_as_uint(s), __float_as_uint(s), false, false);
      qn = sqrtf(__uint_as_float(rr[0]) + __uint_as_float(rr[1])) * 1.001f; }
    float knpref;
    { const f32x2 kp = *(const f32x2*)(knp + ((size_t)bh * 64 + lane) * 2); float v = sqrtf(kp.x + kp.y) * 1.001f;
#pragma unroll
      for (int o = 1; o < 64; o <<= 1) { const float t = __shfl_up(v, o); if (lane >= o) v = fmaxf(v, t); }
      knpref = v; }
    f32x16 o0, o1;
#pragma unroll
    for (int i = 0; i < 16; ++i) { o0[i] = 0.f; o1[i] = 0.f; }
    float R = 0.f;
    const int nkb = (q0 + 128) / 64;
    const int srow = tid >> 3, sch = tid & 7;
    const bf16_t* sg = QKV + (rowbase + srow) * 1536 + 512 + (2 * hp) * 64 + sch * 8;
    const unsigned soff = srow * KPITCH + sch * 16;
    LAS unsigned* fl = (LAS unsigned*)(lds + 2 * ATT_BUF);
    u32x4 st0, st1, st2, st3;
#define ATT_LOAD(kb_) do { const bf16_t* g_ = sg + (size_t)(kb_) * 64 * 1536; st0 = *(const u32x4*)g_; st1 = *(const u32x4*)(g_ + 512); st2 = *(const u32x4*)(g_ + 64); st3 = *(const u32x4*)(g_ + 576); } while (0)
#define ATT_STORE(buf_) do { LAS unsigned char* d_ = lds + (buf_) * ATT_BUF + soff; *(LAS u32x4*)d_ = st0; *(LAS u32x4*)(d_ + KVBUF) = st1; *(LAS u32x4*)(d_ + 2 * KVBUF) = st2; *(LAS u32x4*)(d_ + 3 * KVBUF) = st3; } while (0)
    ATT_LOAD(nkb - 1); ATT_STORE(0);
    __syncthreads();
    const int vq = (lane & 15) >> 2, vp = lane & 3, vblk = (lane >> 4) & 1;
    const unsigned vlane = (4 * hi + vq) * KPITCH + vblk * 32 + vp * 8;
    const float lomask = hi ? 0.f : 1.f;
    for (int it = 0; it < nkb; ++it) {
        const int kb = nkb - 1 - it, cur = it & 1, s0 = kb * 64;
        const bool more = (it + 1 < nkb);
        if (more) ATT_LOAD(kb - 1);
        if (s0 < wq0 + 32) {
            const LAS unsigned char* Kb = lds + cur * ATT_BUF + hsel * (2 * KVBUF); const LAS unsigned char* Vb = Kb + KVBUF;
            f32x16 z0, z1;
#pragma unroll
            for (int i = 0; i < 16; ++i) { z0[i] = 0.f; z1[i] = 0.f; }
#pragma unroll
            for (int d0 = 0; d0 < 4; ++d0) {
                const bf16x8 ka = *(const LAS bf16x8*)(Kb + r32 * KPITCH + d0 * 32 + hi * 16);
                const bf16x8 kc = *(const LAS bf16x8*)(Kb + (32 + r32) * KPITCH + d0 * 32 + hi * 16);
                z0 = MFMA32(ka, qf[d0], z0); z1 = MFMA32(kc, qf[d0], z1);
            }
            if (s0 + 63 >= wq0) {
#pragma unroll
                for (int i = 0; i < 16; ++i) { const int kv = s0 + crow(i, hi); if (kv >= tq) z0[i] = -INFINITY; if (kv + 32 >= tq) z1[i] = -INFINITY; }
            }
            f32x16 c0, c1; float Glo[8], Ghi[8];
#pragma unroll
            for (int g = 0; g < 4; ++g) {
                float a3 = softplus2(z0[4 * g + 3]), a2 = softplus2(z0[4 * g + 2]) + a3, a1 = softplus2(z0[4 * g + 1]) + a2, a0 = softplus2(z0[4 * g]) + a1;
                c0[4 * g + 3] = a3; c0[4 * g + 2] = a2; c0[4 * g + 1] = a1; c0[4 * g] = a0;
                auto rr = __builtin_amdgcn_permlane32_swap(__float_as_uint(a0), __float_as_uint(a0), false, false);
                Glo[g] = __uint_as_float(rr[0]); Ghi[g] = __uint_as_float(rr[1]);
                float b3 = softplus2(z1[4 * g + 3]), b2 = softplus2(z1[4 * g + 2]) + b3, b1 = softplus2(z1[4 * g + 1]) + b2, b0 = softplus2(z1[4 * g]) + b1;
                c1[4 * g + 3] = b3; c1[4 * g + 2] = b2; c1[4 * g + 1] = b1; c1[4 * g] = b0;
                auto ss_ = __builtin_amdgcn_permlane32_swap(__float_as_uint(b0), __float_as_uint(b0), false, false);
                Glo[4 + g] = __uint_as_float(ss_[0]); Ghi[4 + g] = __uint_as_float(ss_[1]);
            }
            float run = R;
            u32x4 pf[2][2];
#pragma unroll
            for (int c = 7; c >= 0; --c) {
                const float base = __builtin_fmaf(Ghi[c], lomask, run);
                const int g = c & 3;
                float a[4];
                if (c >= 4) {
#pragma unroll
                    for (int j = 0; j < 4; ++j) a[j] = __builtin_amdgcn_exp2f(z1[4 * g + j] - (c1[4 * g + j] + base));
                    if (g & 1) { pf[1][g >> 1].z = pk2(a[0], a[1]); pf[1][g >> 1].w = pk2(a[2], a[3]); } else { pf[1][g >> 1].x = pk2(a[0], a[1]); pf[1][g >> 1].y = pk2(a[2], a[3]); }
                } else {
#pragma unroll
                    for (int j = 0; j < 4; ++j) a[j] = __builtin_amdgcn_exp2f(z0[4 * g + j] - (c0[4 * g + j] + base));
                    if (g & 1) { pf[0][g >> 1].z = pk2(a[0], a[1]); pf[0][g >> 1].w = pk2(a[2], a[3]); } else { pf[0][g >> 1].x = pk2(a[0], a[1]); pf[0][g >> 1].y = pk2(a[2], a[3]); }
                }
                run += Glo[c] + Ghi[c];
            }
            R = run;
#pragma unroll
            for (int kt = 0; kt < 2; ++kt)
#pragma unroll
                for (int s = 0; s < 2; ++s) {
                    const LAS unsigned char* vb = Vb + vlane + (32 * kt + 16 * s) * KPITCH;
                    const s16x4 l0 = vtr(vb), h0 = vtr(vb + 8 * KPITCH), l1 = vtr(vb + 64), h1 = vtr(vb + 64 + 8 * KPITCH);
                    const bf16x8 v0 = __builtin_shufflevector(l0, h0, 0, 1, 2, 3, 4, 5, 6, 7), v1 = __builtin_shufflevector(l1, h1, 0, 1, 2, 3, 4, 5, 6, 7);
                    const bf16x8 pb = __builtin_bit_cast(bf16x8, pf[kt][s]);
                    o0 = MFMA32(v0, pb, o0); o1 = MFMA32(v1, pb, o1);
                }
        }
        if (more) { ATT_STORE(cur ^ 1);
            const float kbound = __uint_as_float(__builtin_amdgcn_readlane(__float_as_uint(knpref), kb - 1));
            const bool ldone = (R - qn * kbound) > 160.f;
            if (lane == 0) fl[cur * 8 + wid] = __all(ldone) ? 1u : 0u; }
        __syncthreads();
        if (more) { const u32x4 fa = *(const LAS u32x4*)(fl + cur * 8), fb = *(const LAS u32x4*)(fl + cur * 8 + 4);
            if ((fa.x & fa.y & fa.z & fa.w & fb.x & fb.y & fb.z & fb.w) != 0u) break; }
    }
    __syncthreads();
#undef ATT_LOAD
#undef ATT_STORE
    bf16_t* op = OUT + (rowbase + tq) * D + CW + h * 64 + 4 * hi;
#pragma unroll
    for (int g = 0; g < 4; ++g) {
        u32x2 w0, w1; w0.x = pk2(o0[4 * g], o0[4 * g + 1]); w0.y = pk2(o0[4 * g + 2], o0[4 * g + 3]); w1.x = pk2(o1[4 * g], o1[4 * g + 1]); w1.y = pk2(o1[4 * g + 2], o1[4 * g + 3]);
        *(u32x2*)(op + 8 * g) = w0; *(u32x2*)(op + 32 + 8 * g) = w1;
    }
}

constexpr int CT = 64, CROWS = 96, CW_OFF = CROWS * 1024, CWROWS = 36;
DI void conv_load_w(const float* cw, LAS unsigned char* lds) {
    f32x2 wv[CWROWS * CW / 2 / 512];
#pragma unroll
    for (int k = 0; k < CWROWS * CW / 2 / 512; ++k) { const int i = threadIdx.x + 512 * k; wv[k] = (f32x2){0.f, 0.f}; if (i < CK * CW / 2) wv[k] = *(const f32x2*)(cw + 2 * i); }
#pragma unroll
    for (int k = 0; k < CWROWS * CW / 2 / 512; ++k) { const int i = threadIdx.x + 512 * k; *(LAS unsigned*)(lds + CW_OFF + 4 * i) = pk2(wv[k].x, wv[k].y); }
}
DI void unpack8(const u32x4 w, f32x2 (&o)[4]) { o[0] = (f32x2){bf_lo(w.x), bf_hi(w.x)}; o[1] = (f32x2){bf_lo(w.y), bf_hi(w.y)}; o[2] = (f32x2){bf_lo(w.z), bf_hi(w.z)}; o[3] = (f32x2){bf_lo(w.w), bf_hi(w.w)}; }
DI void conv_item(const bf16_t* U, bf16_t* OUT, const float* cb, const float* lg, const float* lb, LAS unsigned char* lds, int item) {
    const int tid = threadIdx.x, lane = tid & 63, wave = tid >> 6;
    const int b = item >> 6, t0 = (item & 63) * CT; const size_t rowbase = (size_t)b * SEQ;
    __syncthreads();
    { u32x4 tv[CROWS * 64 / 512];
#pragma unroll
      for (int k = 0; k < CROWS * 64 / 512; ++k) { const int i = tid + 512 * k, r = i >> 6, c16 = i & 63, s = t0 - (CK - 1) + r;
          tv[k] = (u32x4){0u, 0u, 0u, 0u}; if (s >= 0 && r < CT + CK - 1) tv[k] = *(const u32x4*)(U + (rowbase + s) * CW + c16 * 8); }
#pragma unroll
      for (int k = 0; k < CROWS * 64 / 512; ++k) { const int i = tid + 512 * k; *(LAS u32x4*)(lds + (i >> 6) * 1024 + (i & 63) * 16) = tv[k]; } }
    __syncthreads();
    f32x2 bias[4], g8[4], b8[4];
#pragma unroll
    for (int j = 0; j < 4; ++j) { bias[j] = *(const f32x2*)(cb + lane * 8 + 2 * j); g8[j] = *(const f32x2*)(lg + lane * 8 + 2 * j); b8[j] = *(const f32x2*)(lb + lane * 8 + 2 * j); }
    for (int grp = 0; grp < 2; ++grp) {
        const int t4 = wave * 8 + grp * 4;
        f32x2 acc[4][4], wv[4][4];
#pragma unroll
        for (int i = 0; i < 4; ++i)
#pragma unroll
            for (int j = 0; j < 4; ++j) { acc[i][j] = bias[j]; wv[i][j] = (f32x2){0.f, 0.f}; }
#pragma unroll 1
        for (int rb = 0; rb < CWROWS; rb += 4) {
#pragma unroll
            for (int q = 0; q < 4; ++q) {
                f32x2 u8[4]; unpack8(*(const LAS u32x4*)(lds + (t4 + rb + q) * 1024 + lane * 16), u8);
                unpack8(*(const LAS u32x4*)(lds + CW_OFF + (rb + q) * 1024 + lane * 16), wv[q]);
#pragma unroll
                for (int i = 0; i < 4; ++i)
#pragma unroll
                    for (int j = 0; j < 4; ++j) acc[i][j] = acc[i][j] + wv[(q - i) & 3][j] * u8[j];
            }
        }
#pragma unroll
        for (int i = 0; i < 4; ++i) {
            float s = 0.f;
#pragma unroll
            for (int j = 0; j < 4; ++j) s += acc[i][j].x + acc[i][j].y;
            const float mean = wave_sum(s) * (1.0f / CW); float s2 = 0.f;
#pragma unroll
            for (int j = 0; j < 4; ++j) { acc[i][j] = acc[i][j] - mean; s2 += acc[i][j].x * acc[i][j].x + acc[i][j].y * acc[i][j].y; }
            const float rstd = __builtin_amdgcn_rsqf(wave_sum(s2) * (1.0f / CW) + EPS);
            unsigned o[4];
#pragma unroll
            for (int j = 0; j < 4; ++j) { const f32x2 yv = acc[i][j] * rstd * g8[j] + b8[j]; o[j] = pk2(yv.x * fast_sigmoid(yv.x), yv.y * fast_sigmoid(yv.y)); }
            u32x4 w; w.x = o[0]; w.y = o[1]; w.z = o[2]; w.w = o[3];
            *(u32x4*)(OUT + (rowbase + t0 + t4 + i) * D + lane * 8) = w;
        }
    }
}

#ifndef MK_CG_ALL
#define MK_CG_ALL 0
#endif
#define PH_IN(k) (lo <= (k) && (k) < hi)
#define XB_TMO      128
#define XB_XCNT(j)  (256  + 64 * (j))
#define XB_XSUB(j)  (1280 + 64 * (j))
#define XB_XGEN(j)  (2304 + 64 * (j))
#define XB_TOP      3328
#define XB_TOPGEN   3392
#define XCD_BAR_WORDS 3456
#define XB_SPIN_CAP (1u << 18)
DI unsigned xb_ld(unsigned* p)              { return __hip_atomic_load(p, __ATOMIC_RELAXED, __HIP_MEMORY_SCOPE_AGENT); }
DI unsigned xb_add(unsigned* p, unsigned v) { return __hip_atomic_fetch_add(p, v, __ATOMIC_RELAXED, __HIP_MEMORY_SCOPE_AGENT); }
DI unsigned xb_xcc_id() { return (unsigned)__builtin_amdgcn_s_getreg((3 << 11) | 20) & 0xFu; }
#define XB_SPIN(cond, bar) do { unsigned _sp = 0; while (cond) { __builtin_amdgcn_s_sleep(1); \
    if ((++_sp & 255u) == 0u) { if (xb_ld(&(bar)[XB_TMO])) break; if (_sp > XB_SPIN_CAP) { atomicAdd(&(bar)[XB_TMO], 1u); break; } } } } while (0)
struct XcdBarrier { unsigned* bar; unsigned x; volatile LAS unsigned* st; };
DI XcdBarrier xcd_barrier_post(unsigned* bar, volatile LAS unsigned* st) {
    XcdBarrier b; b.bar = bar; b.x = xb_xcc_id(); b.st = st;
    if (threadIdx.x == 0) (void)xb_add(&bar[XB_XCNT(b.x)], 1u);
    return b;
}
DI void xcd_barrier_complete(unsigned* bar, unsigned x, unsigned& nloc, unsigned& nx) {
    const unsigned G = gridDim.x * gridDim.y * gridDim.z;
    unsigned sum, cnt, mine, sp = 0u;
    for (;;) {
        sum = 0u; cnt = 0u; mine = 0u;
#pragma unroll
        for (unsigned j = 0; j < 16; ++j) { const unsigned c = xb_ld(&bar[XB_XCNT(j)]); sum += c; cnt += (c > 0u) ? 1u : 0u; mine = (j == x) ? c : mine; }
        if (sum == G) break;
        __builtin_amdgcn_s_sleep(1);
        if ((++sp & 255u) == 0u) { if (xb_ld(&bar[XB_TMO])) break; if (sp > XB_SPIN_CAP) { atomicAdd(&bar[XB_TMO], 1u); break; } }
    }
    nloc = mine > 0u ? mine : 1u; nx = cnt > 0u ? cnt : 1u;
}
DI void xcd_barrier(const XcdBarrier& b) {
    asm volatile("s_waitcnt vmcnt(0)" ::: "memory");
    __syncthreads();
    if (threadIdx.x == 0) {
        unsigned* bar = b.bar;
        __builtin_amdgcn_s_waitcnt(0);
        unsigned nloc = b.st[0], nx = b.st[1];
        if (nloc == 0u) { xcd_barrier_complete(bar, b.x, nloc, nx); b.st[0] = nloc; b.st[1] = nx; }
        const unsigned old = xb_add(&bar[XB_XSUB(b.x)], 1u);
        const unsigned gen = old / nloc;
        if (old + 1u == (gen + 1u) * nloc) {
            __builtin_amdgcn_fence(__ATOMIC_RELEASE, "agent");
            asm volatile("s_waitcnt vmcnt(0)" ::: "memory");
            const unsigned og = xb_add(&bar[XB_TOP], 1u);
            const unsigned tg = og / nx;
            if (og + 1u == (tg + 1u) * nx) xb_add(&bar[XB_TOPGEN], 1u);
            else XB_SPIN(xb_ld(&bar[XB_TOPGEN]) == tg, bar);
            __builtin_amdgcn_fence(__ATOMIC_ACQUIRE, "agent");
            xb_add(&bar[XB_XGEN(b.x)], 1u);
            asm volatile("s_waitcnt vmcnt(0)" ::: "memory");
        } else {
            XB_SPIN(xb_ld(&bar[XB_XGEN(b.x)]) == gen, bar);
            __builtin_amdgcn_fence(__ATOMIC_ACQUIRE, "agent");
            asm volatile("s_waitcnt vmcnt(0)" ::: "memory");
        }
    }
    __syncthreads();
}
#ifndef MK_DUP
#define MK_DUP 0
#endif
#define PH_SEAM(k) do { if (PH_IN(k) && PH_IN((k) + 1)) { if (MK_CG_ALL || p.out == nullptr) grid.sync(); else xcd_barrier(bar);     } } while (0)
template <int L>
DI void layer_phases(const Params& p, LAS unsigned char* lds, const int lo, const int hi, cg::grid_group& grid, const XcdBarrier& bar) {
    unsigned char* ws = p.ws;
    float* mod = (float*)(ws + OFF_MOD); float* ssb = (float*)(ws + OFF_SS);
    bf16_t* H = (bf16_t*)(ws + OFF_H); bf16_t* MIX = (bf16_t*)(ws + OFF_MIX); bf16_t* XB = (bf16_t*)(ws + OFF_XB);
    bf16_t* Ub = (bf16_t*)(ws + OFF_U); bf16_t* QKV = (bf16_t*)(ws + OFF_QKV); bf16_t* RATIO = (bf16_t*)(ws + OFF_RATIO); bf16_t* SGA = (bf16_t*)(ws + OFF_SGA); bf16_t* HID = (bf16_t*)(ws + OFF_HID);
    const float* modl = mod + (size_t)L * NB * 6144;
    constexpr int P0 = 2 + 8 * L;
    if (PH_IN(P0)) { pg8::StaticOrder S; EpiIn E{Ub, QKV, RATIO, SGA, (float*)(ws + OFF_KN)}; S.init(M, INC, gridDim.x, blockIdx.x);
        for (int rep = 0; rep < ((L == 0 && (MK_DUP & 4)) ? 2 : 1); ++rep) pg8::gemm_phase(lds, pg8::Gemm{H, (const bf16_t*)(ws + OFF_WIN) + (size_t)L * INC * D, M, INC, D}, S, E); }
    PH_SEAM(P0);
    if (PH_IN(P0 + 1)) for (int rep = 0; rep < ((L == 0 && (MK_DUP & 2)) ? 2 : 1); ++rep) {
        __syncthreads();
        for (int it = blockIdx.x; it < 2048; it += gridDim.x) attn_block(QKV, (const float*)(ws + OFF_KN), MIX, lds, it >> 7, (it >> 5) & 3, it & 31);
        conv_load_w(p.conv_w + (size_t)L * CK * CW, lds);
        for (int it = blockIdx.x; it < 1024; it += gridDim.x)
            conv_item(Ub, MIX, p.conv_b + L * CW, p.conv_ln_g + L * CW, p.conv_ln_b + L * CW, lds, it);
    }
    PH_SEAM(P0 + 1);
    if (PH_IN(P0 + 2)) { pg8::StaticOrder S; EpiMix E{RATIO, SGA, H}; S.init(M, D, gridDim.x, blockIdx.x);
        for (int rep = 0; rep < ((L == 0 && (MK_DUP & 4)) ? 2 : 1); ++rep) pg8::gemm_phase(lds, pg8::Gemm{MIX, (const bf16_t*)(ws + OFF_WMIX) + (size_t)L * D * D, M, D, D}, S, E); }
    PH_SEAM(P0 + 2);
    if (PH_IN(P0 + 3)) { pg8::StaticOrder S; EpiY E{MIX, ssb + (size_t)(2 * L) * M * 16}; S.init(M, D, gridDim.x, blockIdx.x);
        for (int rep = 0; rep < ((L == 0 && (MK_DUP & 4)) ? 2 : 1); ++rep) pg8::gemm_phase(lds, pg8::Gemm{H, (const bf16_t*)(ws + OFF_WO) + (size_t)L * D * D, M, D, D}, S, E); }
    PH_SEAM(P0 + 3);
    if (PH_IN(P0 + 4)) rowpass(p.x, L == 0 ? nullptr : XB, MIX, ssb + (size_t)(2 * L) * M * 16, modl + 2048, p.post_mix_g + L * D, nullptr, XB, p.pre_ffn_g + L * D, modl + 4096, modl + 3072, H);
    PH_SEAM(P0 + 4);
    if (PH_IN(P0 + 5)) { pg8::StaticOrder S; EpiF1 E{HID}; S.init(M, 2 * DFF, gridDim.x, blockIdx.x);
        for (int rep = 0; rep < ((L == 0 && (MK_DUP & 4)) ? 2 : 1); ++rep) pg8::gemm_phase(lds, pg8::Gemm{H, (const bf16_t*)(ws + OFF_WF1) + (size_t)L * 2 * DFF * D, M, 2 * DFF, D}, S, E); }
    PH_SEAM(P0 + 5);
    if (PH_IN(P0 + 6)) { pg8::StaticOrder S; EpiY E{MIX, ssb + (size_t)(2 * L + 1) * M * 16}; S.init(M, D, gridDim.x, blockIdx.x);
        for (int rep = 0; rep < ((L == 0 && (MK_DUP & 4)) ? 2 : 1); ++rep) pg8::gemm_phase(lds, pg8::Gemm{HID, (const bf16_t*)(ws + OFF_WF2) + (size_t)L * D * DFF, M, D, DFF}, S, E); }
    PH_SEAM(P0 + 6);
    if (PH_IN(P0 + 7)) { constexpr bool lastl = (L == DEPTH - 1); const float* modn = modl + (size_t)NB * 6144;
        rowpass(nullptr, XB, MIX, ssb + (size_t)(2 * L + 1) * M * 16, modl + 5120, p.post_ffn_g + L * D, p.out, lastl ? nullptr : XB,
                lastl ? nullptr : p.pre_mix_g + (lastl ? 0 : L + 1) * D, modn + 1024, modn, H); }
    if (L + 1 < DEPTH) PH_SEAM(P0 + 7);
}

__global__ __launch_bounds__(512, 2) void fwd_megakernel(Params p) {
    extern __shared__ __attribute__((aligned(16))) unsigned char shm[];
    LAS unsigned char* lds = (LAS unsigned char*)shm;
    cg::grid_group grid = cg::this_grid();
    const int lo = p.ph_lo, hi = p.ph_hi;
    volatile LAS unsigned* st = (volatile LAS unsigned*)(lds + 135168);
    if (threadIdx.x < 4) st[threadIdx.x] = 0u;
    __syncthreads();
    XcdBarrier bar; bar.bar = (unsigned*)(p.ws + OFF_BAR); bar.x = 0; bar.st = st;
    if (hi - lo > 2) bar = xcd_barrier_post((unsigned*)(p.ws + OFF_BAR), st);
    if (PH_IN(0)) { phase0(p, lds); if (MK_DUP & 1) { __syncthreads(); phase0(p, lds); } }
    PH_SEAM(0);
    if (PH_IN(1)) { float* mod = (float*)(p.ws + OFF_MOD); for (int rep = 0; rep < ((MK_DUP & 1) ? 2 : 1); ++rep) rowpass(p.x, nullptr, nullptr, nullptr, nullptr, nullptr, nullptr, nullptr, p.pre_mix_g, mod + 1024, mod, (bf16_t*)(p.ws + OFF_H)); }
    PH_SEAM(1);
    layer_phases<0>(p, lds, lo, hi, grid, bar);
    layer_phases<1>(p, lds, lo, hi, grid, bar);
}


#ifndef MK_CHECK
#define MK_CHECK 0
#endif
#if MK_CHECK
DI float bfr(float x) { return bf_lo(pk2(x, 0.f)); }
DI float ldbf(const bf16_t* p) { return __uint_as_float(((unsigned)*p) << 16); }
DI unsigned hsh(unsigned x) { x ^= x >> 16; x *= 0x7feb352du; x ^= x >> 15; x *= 0x846ca68bu; x ^= x >> 16; return x; }
DI void diag_max(const Params& p, int stage, float got, float ref) {
    float e = fabsf(got - ref) / (fabsf(ref) + 0.05f); if (!(e == e)) e = 1e9f;
    atomicMax((unsigned*)(p.ws + OFF_DIAG) + stage, __float_as_uint(e));
}
DI float dotA(const bf16_t* a, const float* w, int ldw, int K) { float s = 0.f; for (int k = 0; k < K; ++k) s += ldbf(a + k) * bfr(w[(size_t)k * ldw]); return s; }
DI float sigm(float x) { return 1.0f / (1.0f + expf(-x)); }
__global__ void chk_kernel(Params p, int stage) {
    const unsigned id = blockIdx.x * blockDim.x + threadIdx.x; const unsigned h1 = hsh(id * 2654435761u + stage * 977u), h2 = hsh(h1 + 12345u);
    unsigned char* ws = p.ws; const float* mod = (const float*)(ws + OFF_MOD); const float* ssb = (const float*)(ws + OFF_SS);
    const bf16_t* H = (const bf16_t*)(ws + OFF_H); const bf16_t* MIX = (const bf16_t*)(ws + OFF_MIX); const bf16_t* Ub = (const bf16_t*)(ws + OFF_U); const bf16_t* QKV = (const bf16_t*)(ws + OFF_QKV);
    const bf16_t* RATIO = (const bf16_t*)(ws + OFF_RATIO); const bf16_t* SGA = (const bf16_t*)(ws + OFF_SGA); const bf16_t* HID = (const bf16_t*)(ws + OFF_HID);
    int row = h1 % M; if ((id & 7) == 0) row = (row & ~4095) + (h2 % 40); const int b = row >> 12;
    if (stage == 1) { const int l = id & 1, bb = (id >> 1) & 15, col = h1 % 6144; float s = p.ada_b[l * 6144 + col];
        for (int k = 0; k < D; ++k) { const float c = p.c[bb * D + k]; s += c * sigm(c) * p.ada_w[((size_t)l * D + k) * 6144 + col]; }
        diag_max(p, 1, mod[(l * NB + bb) * 6144 + col], s); }
    if (stage == 2) { float q = 0.f; for (int k = 0; k < D; ++k) { const float v = p.x[(size_t)row * D + k]; q += v * v; }
        const float rs = 1.0f / sqrtf(q / D + EPS); const int col = h2 % D;
        const float ref = p.x[(size_t)row * D + col] * rs * p.pre_mix_g[col] * (1.0f + mod[b * 6144 + 1024 + col]) + mod[b * 6144 + col];
        diag_max(p, 2, ldbf(H + (size_t)row * D + col), ref); }
    if (stage == 3) { const bf16_t* a = H + (size_t)row * D; const int t = id & 3;
        if (t == 0) { const int ch = h2 % CW; const float v = dotA(a, p.w_in + ch, INC, D), g = dotA(a, p.w_in + 512 + ch, INC, D); diag_max(p, 3, ldbf(Ub + (size_t)row * CW + ch), v * sigm(g)); }
        else if (t == 1) { const int c = h2 % 1536; const float v = dotA(a, p.w_in + 1024 + c, INC, D) * (c < 512 ? 0.125f * LOG2E : 1.0f); diag_max(p, 3, ldbf(QKV + (size_t)row * 1536 + c), v); }
        else { const int ch = h2 % D; const float gc = dotA(a, p.w_in + 2560 + ch, INC, D), ga = dotA(a, p.w_in + 3584 + ch, INC, D);
            if (t == 2) diag_max(p, 3, ldbf(RATIO + (size_t)row * D + ch), sigm(gc) / sigm(ga)); else diag_max(p, 3, ldbf(SGA + (size_t)row * D + ch), sigm(ga)); } }
    if (stage == 4) { const int s0 = row & 4095; float s1 = 0.f, s2 = 0.f; const int chs = h2 % CW; float vs = 0.f;
        for (int ch = 0; ch < CW; ++ch) { float a = p.conv_b[ch];
            for (int k = 0; k < CK; ++k) { const int s = s0 - 30 + k; if (s >= 0) a += bfr(p.conv_w[k * CW + ch]) * ldbf(Ub + ((size_t)(row - s0 + s)) * CW + ch); }
            s1 += a; s2 += a * a; if (ch == chs) vs = a; }
        const float mean = s1 / CW, var = s2 / CW - mean * mean; const float yv = (vs - mean) / sqrtf(var + EPS) * p.conv_ln_g[chs] + p.conv_ln_b[chs];
        diag_max(p, 4, ldbf(MIX + (size_t)row * D + chs), yv * sigm(yv)); }
    if (stage == 5) { const int hh = h2 & 7, d4 = ((h2 >> 3) & 15) * 4; int t = row & 4095; if ((id & 3) == 1) t &= 255; if ((id & 3) == 2) t &= 63; const size_t rb = (size_t)b * SEQ;
        const bf16_t* q = QKV + (rb + t) * 1536 + hh * 64; float o0 = 0.f, o1 = 0.f, o2 = 0.f, o3 = 0.f, run = 0.f;
        for (int s = t - 1; s >= 0; --s) { const bf16_t* kk = QKV + (rb + s) * 1536 + 512 + hh * 64; float z = 0.f; for (int d = 0; d < 64; ++d) z += ldbf(q + d) * ldbf(kk + d);
            run += fmaxf(z, 0.f) + log2f(1.0f + exp2f(-fabsf(z))); const float a = exp2f(z - run); const bf16_t* vv = kk + 512 + d4;
            o0 += a * ldbf(vv); o1 += a * ldbf(vv + 1); o2 += a * ldbf(vv + 2); o3 += a * ldbf(vv + 3); if (run > 200.f) break; }
        const bf16_t* o = MIX + (rb + t) * D + CW + hh * 64 + d4;
        diag_max(p, 5, ldbf(o), o0); diag_max(p, 5, ldbf(o + 1), o1); diag_max(p, 5, ldbf(o + 2), o2); diag_max(p, 5, ldbf(o + 3), o3); }
    if (stage == 6) { const int col = h2 % D; const bf16_t* a = MIX + (size_t)row * D; const float yc = dotA(a, p.w_conv_out + col, D, CW), ya = dotA(a + CW, p.w_att_out + col, D, CW);
        diag_max(p, 6, ldbf(H + (size_t)row * D + col), ldbf(SGA + (size_t)row * D + col) * (ldbf(RATIO + (size_t)row * D + col) * yc + ya)); }
    if (stage == 7 || stage == 10) { const int col = h2 % D; const bool f = (stage == 10);
        const float ref = f ? dotA(HID + (size_t)row * DFF, p.w_ffn_out + col, D, DFF) : dotA(H + (size_t)row * D, p.w_o + col, D, D);
        diag_max(p, stage, ldbf(MIX + (size_t)row * D + col), ref);
        if ((id & 15) == 0) { float q = 0.f; for (int k = 0; k < D; ++k) { const float v = ldbf(MIX + (size_t)row * D + k); q += v * v; } float sq = 0.f; for (int k = 0; k < 16; ++k) sq += ssb[((size_t)(f ? M : 0) + row) * 16 + k]; diag_max(p, stage, sq, q); } }
    if (stage == 8 || stage == 11) { const bool f = (stage == 11); const int col = h2 % D; const float* xin = f ? p.out : p.x;
        float sq = 0.f; for (int k = 0; k < 16; ++k) sq += ssb[((size_t)(f ? M : 0) + row) * 16 + k];
        const float rs = 1.0f / sqrtf(sq / D + EPS);
        if (!f) { const float ref = xin[(size_t)row * D + col] + mod[b * 6144 + 2048 + col] * ldbf(MIX + (size_t)row * D + col) * rs * p.post_mix_g[col]; diag_max(p, 8, p.out[(size_t)row * D + col], ref); }
        float q = 0.f; for (int k = 0; k < D; ++k) { const float v = p.out[(size_t)row * D + k]; q += v * v; }
        const float r2 = 1.0f / sqrtf(q / D + EPS);
        const float ref = f ? p.out[(size_t)row * D + col] * r2 * p.pre_mix_g[D + col] * (1.0f + mod[(NB + b) * 6144 + 1024 + col]) + mod[(NB + b) * 6144 + col]
                            : p.out[(size_t)row * D + col] * r2 * p.pre_ffn_g[col] * (1.0f + mod[b * 6144 + 4096 + col]) + mod[b * 6144 + 3072 + col];
        diag_max(p, stage, ldbf(H + (size_t)row * D + col), ref); }
    if (stage == 9) { const int ch = h2 % DFF; const bf16_t* a = H + (size_t)row * D; const float g = dotA(a, p.w_ffn_in + ch, 2 * DFF, D), u = dotA(a, p.w_ffn_in + DFF + ch, 2 * DFF, D);
        diag_max(p, 9, ldbf(HID + (size_t)row * DFF + ch), g * sigm(g) * u); }
}
__global__ void chk_report(Params p) {
    const unsigned* dg = (const unsigned*)(p.ws + OFF_DIAG); int first = 0, second = 0;
    for (int s = 1; s <= 11; ++s) if (__uint_as_float(dg[s]) > 0.04f) { if (!first) first = s; else if (!second) second = s; }
    if (first) p.out[0] = 1000.0f * (10 * (first % 10) + (second % 10)) + (first >= 10 ? 500.f : 0.f);
}
#endif

#ifndef MK_PER_PHASE
#define MK_PER_PHASE 0
#endif
extern "C" void kernel_launch(void* const* d_in, const int* in_sizes, int n_in, void* d_out, int out_size, void* d_ws, size_t ws_size, hipStream_t stream) {
    static int grid = 0;
    if (grid == 0) {
        if (n_in != 18 || in_sizes[0] != M * D || out_size != M * D || ws_size < WS_END) { fprintf(stderr, "kernel_launch: unexpected shapes (n_in %d in0 %d out %d ws %zu need %zu)\n", n_in, in_sizes[0], out_size, ws_size, (size_t)WS_END); grid = -1; return; }
        int dev = 0, cus = 0, per_cu = 0;
        hipGetDevice(&dev); hipDeviceGetAttribute(&cus, hipDeviceAttributeMultiprocessorCount, dev);
        if (hipFuncSetAttribute((const void*)fwd_megakernel, hipFuncAttributeMaxDynamicSharedMemorySize, LDS_BYTES) != hipSuccess) { fprintf(stderr, "kernel_launch: hipFuncSetAttribute failed\n"); grid = -1; return; }
        if (hipOccupancyMaxActiveBlocksPerMultiprocessor(&per_cu, (const void*)fwd_megakernel, 512, LDS_BYTES) != hipSuccess || per_cu < 1) { fprintf(stderr, "kernel_launch: occupancy query failed (%d)\n", per_cu); (void)hipGetLastError(); per_cu = 1; }
        grid = cus * per_cu;
    }
    if (grid < 0) return;
    (void)hipMemsetAsync((unsigned char*)d_ws + OFF_DIAG, 0, ZERO_BYTES, stream);
    Params p{};
    const float** pp = (const float**)&p;
    for (int i = 0; i < 18; ++i) pp[i] = (const float*)d_in[i];
    p.out = (float*)d_out; p.ws = (unsigned char*)d_ws;
#if MK_PER_PHASE
    for (int ph = 0; ph < NPHASE; ++ph) { p.ph_lo = ph; p.ph_hi = ph + 1;
        hipLaunchKernelGGL(fwd_megakernel, dim3(grid), dim3(512), LDS_BYTES, stream, p);
#if MK_CHECK
        { Params q = p; q.ph_lo = 0; q.ph_hi = 0;
          auto CH = [&](int st) { hipLaunchKernelGGL(chk_kernel, dim3(8), dim3(64), 0, stream, q, st); };
          if (ph == 1) { CH(1); CH(2); } if (ph == 2) CH(3); if (ph == 3) { CH(4); CH(5); } if (ph == 4) CH(6); if (ph == 5) CH(7); if (ph == 6) CH(8);
          if (ph == 7) CH(9); if (ph == 8) CH(10); if (ph == 9) CH(11);
          if (ph == NPHASE - 1) hipLaunchKernelGGL(chk_report, dim3(1), dim3(1), 0, stream, q); }
#endif
    }
#else
    p.ph_lo = 0; p.ph_hi = NPHASE;
    void* args[] = {&p};
    hipError_t e = hipLaunchCooperativeKernel((const void*)fwd_megakernel, dim3(grid), dim3(512), args, LDS_BYTES, stream);
    if (e != hipSuccess) fprintf(stderr, "cooperative launch failed: %s (grid %d)\n", hipGetErrorString(e), grid);
#endif
}
```
